# Optimizing an MI355X kernel written in HIP

```python
import math
import jax, jax.numpy as jnp
from jax import lax
import numpy as np

D_MODEL = 1024
BATCH = 4
SEQ = 8192
DEPTH = 2

HEAD_DIM = 64
Q_HEADS = 8
KV_HEADS = 2
GROUP = Q_HEADS // KV_HEADS
ATTN_WIDTH = Q_HEADS * HEAD_DIM
KV_WIDTH = KV_HEADS * HEAD_DIM
WINDOW = 128
BLOCK = 128
POOL_WIDTH = D_MODEL - ATTN_WIDTH
POOL_WINDOWS = (2, 4, 8, 16)
POOL_GROUPS = len(POOL_WINDOWS)
POOL_GC = POOL_WIDTH // POOL_GROUPS
EVEN_IN = ATTN_WIDTH + 2 * KV_WIDTH + ATTN_WIDTH + POOL_WIDTH + POOL_WIDTH
EVEN_MIX = ATTN_WIDTH + POOL_WIDTH
CONV_WIDTH = D_MODEL
CONV_K = 31
ODD_IN = 3 * CONV_WIDTH
EPS = 1e-6
NEG = -1e30
N_EVEN = (DEPTH + 1) // 2
N_ODD = DEPTH // 2

kernel_name = "hybrid_swa_pool_conformer_sandwich"


def rms_norm(x, g):
    xf = x.astype(jnp.float32)
    y = xf * lax.rsqrt(jnp.mean(xf * xf, axis=-1, keepdims=True) + EPS)
    return (y * g.astype(jnp.float32)).astype(x.dtype)


def alibi_slopes(n):
    return jnp.exp2(-8.0 * jnp.arange(1, n + 1, dtype=jnp.float32) / n)


def sliding_window_attention(q, k, v, sinks):
    B, S, _ = q.shape
    nb = S // BLOCK
    q = q.reshape(B, nb, BLOCK, KV_HEADS, GROUP, HEAD_DIM)
    k = k.reshape(B, nb, BLOCK, KV_HEADS, HEAD_DIM)
    v = v.reshape(B, nb, BLOCK, KV_HEADS, HEAD_DIM)
    kpad = jnp.zeros_like(k[:, :1])
    vpad = jnp.zeros_like(v[:, :1])
    kk = jnp.concatenate([jnp.concatenate([kpad, k[:, :-1]], axis=1), k], axis=2)
    vv = jnp.concatenate([jnp.concatenate([vpad, v[:, :-1]], axis=1), v], axis=2)
    scores = jnp.einsum('bnqkgd,bnskd->bnkgqs', q, kk).astype(jnp.float32) * (HEAD_DIM ** -0.5)
    qi = jnp.arange(BLOCK)[:, None] + BLOCK
    sj = jnp.arange(2 * BLOCK)[None, :]
    dist = qi - sj
    key_pos = jnp.arange(nb)[:, None, None] * BLOCK + sj[None] - BLOCK
    valid = (dist >= 0)[None] & (dist < WINDOW)[None] & (key_pos >= 0)
    slopes = alibi_slopes(Q_HEADS).reshape(KV_HEADS, GROUP)
    bias = -slopes[:, :, None, None] * dist.astype(jnp.float32)
    scores = jnp.where(valid[None, :, None, None], scores + bias, NEG)
    sink = sinks.astype(jnp.float32).reshape(KV_HEADS, GROUP)[None, None, :, :, None, None]
    mx = jnp.maximum(jnp.max(scores, axis=-1, keepdims=True), sink)
    p = jnp.exp(scores - mx)
    p = p / (jnp.sum(p, axis=-1, keepdims=True) + jnp.exp(sink - mx))
    out = jnp.einsum('bnkgqs,bnskd->bnqkgd', p.astype(vv.dtype), vv)
    return out.reshape(B, S, ATTN_WIDTH)


def multiscale_pool(u, pool_w, pool_scale):
    B, S, _ = u.shape
    uf = u.astype(jnp.float32).reshape(B, S, POOL_GROUPS, POOL_GC)
    cs = jnp.concatenate([jnp.zeros_like(uf[:, :1]), jnp.cumsum(uf, axis=1)], axis=1)
    t = jnp.arange(S)[:, None]
    win = jnp.array(POOL_WINDOWS, dtype=jnp.int32)[None, :]
    lo = jnp.maximum(t + 1 - win, 0)
    cnt = (t + 1 - lo).astype(jnp.float32)
    lower = cs[:, lo, jnp.arange(POOL_GROUPS)[None, :]]
    pooled = (cs[:, 1:] - lower) / cnt[None, :, :, None] - uf
    y = jnp.einsum('bsgc,gcd->bsgd', pooled, pool_w.astype(jnp.float32))
    y = y * pool_scale.astype(jnp.float32).reshape(POOL_GROUPS, POOL_GC)
    return y.reshape(B, S, POOL_WIDTH).astype(u.dtype)


def even_mixer(h, w_in, sinks, pool_w, pool_scale, w_out):
    proj = h @ w_in
    splits = np.cumsum([ATTN_WIDTH, KV_WIDTH, KV_WIDTH, ATTN_WIDTH, POOL_WIDTH]).tolist()
    q, k, v, ga, u, gb = jnp.split(proj, splits, axis=-1)
    ya = sliding_window_attention(q, k, v, sinks).astype(h.dtype) * jax.nn.silu(ga)
    yb = multiscale_pool(u, pool_w, pool_scale) * jax.nn.silu(gb)
    return jnp.concatenate([ya, yb], axis=-1) @ w_out


def odd_mixer(h, w_in, dw_w, dw_b, ln_g, ln_b, w_out):
    proj = h @ w_in
    a, b, gate = jnp.split(proj, [CONV_WIDTH, 2 * CONV_WIDTH], axis=-1)
    glu = a * jax.nn.sigmoid(b)
    conv = lax.conv_general_dilated(
        glu, dw_w.astype(glu.dtype), window_strides=(1,), padding=[(CONV_K - 1, 0)],
        dimension_numbers=('NWC', 'WIO', 'NWC'), feature_group_count=CONV_WIDTH)
    cf = conv.astype(jnp.float32) + dw_b.astype(jnp.float32)
    mu = jnp.mean(cf, axis=-1, keepdims=True)
    var = jnp.mean(jnp.square(cf - mu), axis=-1, keepdims=True)
    cn = (cf - mu) * lax.rsqrt(var + EPS) * ln_g.astype(jnp.float32) + ln_b.astype(jnp.float32)
    y = jax.nn.silu(cn).astype(h.dtype) * jax.nn.silu(gate)
    return y @ w_out


def setup_inputs(seed: int = 0) -> dict:
    key = jax.random.key(seed)
    ks = jax.random.split(key, 16)
    f32 = jnp.float32
    nrm = lambda k, shape, s: jax.random.normal(k, shape, f32) * s
    return {
        'x': nrm(ks[0], (BATCH, SEQ, D_MODEL), 1.0),
        'pre_norm': 1.0 + nrm(ks[1], (DEPTH, D_MODEL), 0.05),
        'post_norm': 1.0 + nrm(ks[2], (DEPTH, D_MODEL), 0.05),
        'a_w_in': nrm(ks[3], (N_EVEN, D_MODEL, EVEN_IN), D_MODEL ** -0.5),
        'a_sinks': nrm(ks[4], (N_EVEN, Q_HEADS), 0.5),
        'b_pool_w': nrm(ks[5], (N_EVEN, POOL_GROUPS, POOL_GC, POOL_GC), POOL_GC ** -0.5),
        'b_pool_scale': 1.0 + nrm(ks[6], (N_EVEN, POOL_WIDTH), 0.1),
        'ab_w_out': nrm(ks[7], (N_EVEN, EVEN_MIX, D_MODEL), EVEN_MIX ** -0.5),
        'c_w_in': nrm(ks[8], (N_ODD, D_MODEL, ODD_IN), D_MODEL ** -0.5),
        'c_dw_w': nrm(ks[9], (N_ODD, CONV_K, 1, CONV_WIDTH), CONV_K ** -0.5),
        'c_dw_b': nrm(ks[10], (N_ODD, CONV_WIDTH), 0.02),
        'c_ln_g': 1.0 + nrm(ks[11], (N_ODD, CONV_WIDTH), 0.05),
        'c_ln_b': nrm(ks[12], (N_ODD, CONV_WIDTH), 0.02),
        'c_w_out': nrm(ks[13], (N_ODD, CONV_WIDTH, D_MODEL), CONV_WIDTH ** -0.5),
    }


def reference(x, pre_norm, post_norm, a_w_in, a_sinks, b_pool_w, b_pool_scale, ab_w_out,
              c_w_in, c_dw_w, c_dw_b, c_ln_g, c_ln_b, c_w_out):
    for layer in range(DEPTH):
        h = rms_norm(x, pre_norm[layer])
        if layer % 2 == 0:
            i = layer // 2
            y = even_mixer(h, a_w_in[i], a_sinks[i], b_pool_w[i], b_pool_scale[i], ab_w_out[i])
        else:
            i = layer // 2
            y = odd_mixer(h, c_w_in[i], c_dw_w[i], c_dw_b[i], c_ln_g[i], c_ln_b[i], c_w_out[i])
        x = x + rms_norm(y, post_norm[layer])
    return x
```

```cpp
#include <hip/hip_runtime.h>
#include <hip/hip_cooperative_groups.h>
#include <cstdio>
#include <cstdint>
namespace cg = cooperative_groups;
#define N_LAUNCH_MODE 1
namespace pg8 {
#define PG8_LAS __attribute__((address_space(3)))
typedef unsigned short bf16_t;
typedef short bf16x8 __attribute__((ext_vector_type(8)));
typedef float f32x4 __attribute__((ext_vector_type(4)));
typedef unsigned u32x4 __attribute__((ext_vector_type(4)));
constexpr int BM = 256, BK = 64, HALF = 128, HTB = HALF * BK * 2  , STAGE_BYTES = 8 * HTB, NXCD = 8, WGM = 8;

__host__ __device__ __forceinline__ int lds_byte(int r, int c) { const int st = (r >> 4) * 2 + (c >> 5), rr = r & 15, cc = c & 31, ob = rr * 64 + cc * 2; return st * 1024 + (ob ^ (((ob >> 9) & 1) << 5)); }
__host__ __device__ __forceinline__ void stage_rc(int b, int& R, int& C) { const int st = b / 1024, sb = b % 1024, swz = sb ^ (((sb >> 9) & 1) << 5); R = (st >> 1) * 16 + swz / 64; C = (st & 1) * 32 + (swz % 64) / 2; }
__host__ __device__ __forceinline__ int perm32(int rho) { const int n = rho >> 4, i = rho & 15; return 8 * (i >> 2) + 4 * n + (i & 3); }

struct Unit { int pm, pn; };
struct Gemm { const bf16_t* A; const bf16_t* Bt; int M, N, K; };

struct StaticOrder {
    int nM, nN, nwg, G, c;
    __host__ __device__ void init(int M, int N, int G_, int c_) { nM = M / BM; nN = N / BM; nwg = nM * nN; G = G_; c = c_; }
    __host__ __device__ bool next(int i, Unit& u) const {
        const long L = (long)i * G + c; if (L >= nwg) return false;
        int wgid = (int)L; { const int q = nwg / NXCD, r = nwg % NXCD, xcd = wgid % NXCD, off = wgid / NXCD; wgid = (xcd < r ? xcd * (q + 1) : r * (q + 1) + (xcd - r) * q) + off; }
        const int nig = WGM * nN, gid = wgid / nig, fm = gid * WGM, gsz = (nM - fm) < WGM ? (nM - fm) : WGM;
        u.pm = fm + ((wgid % nig) % gsz); u.pn = (wgid % nig) / gsz; return true;
    }
    __device__ __forceinline__ void a_ready(const Unit&) const {}
    __device__ __forceinline__ void done(const Unit&) const {}
};

__device__ __forceinline__ unsigned cvt_pk_bf16(float lo, float hi) { unsigned r; asm volatile("v_cvt_pk_bf16_f32 %0, %1, %2" : "=v"(r) : "v"(lo), "v"(hi)); return r; }
typedef float f32x2 __attribute__((ext_vector_type(2)));
__device__ __forceinline__ f32x2 gelu_pk(f32x2 v) {
    const f32x2 av = __builtin_elementwise_abs(v), d = av * 0.2316418882f + 1.0f;
    f32x2 t; t.x = __builtin_amdgcn_rcpf(d.x); t.y = __builtin_amdgcn_rcpf(d.y);
    f32x2 q = t * 0.5307027145f + (-0.7265760135f); q = q * t + 0.7107068705f; q = q * t + (-0.142248368f); q = q * t + 0.127414796f; q = q * t;
    const f32x2 s = (v * v) * (-0.72134752044f);
    f32x2 e; e.x = __builtin_amdgcn_exp2f(s.x); e.y = __builtin_amdgcn_exp2f(s.y);
    const f32x2 m = v * (q * e), r = v - m;
    f32x2 o; o.x = v.x < 0.f ? m.x : r.x; o.y = v.y < 0.f ? m.y : r.y; return o;
}

template <int ACT  > struct EpiBf16 {
    static constexpr bool PERM = true, AFTER_DRAIN = false; static_assert(ACT == 0 || ACT == 1, "EpiBf16: ACT is 0 (none) or 1 (gelu_pk)");
    bf16_t* O; int ldc; const float* bias; int split_cols; size_t split_stride; float scale0;
    __device__ __forceinline__ void operator()(const f32x4 (&acc)[2][2][4][2], const Unit& u, int wr, int wc, int fr, int fq) const {
        const int row0 = u.pm * BM + wr * 64 + fr; int colt = u.pn * BM; bf16_t* base = O;
        float sc = 1.f; if (split_cols) { const int t = colt / split_cols; base += (size_t)t * split_stride; colt -= t * split_cols; if (t == 0) sc = scale0; }
        const int col0 = colt + wc * 32 + 8 * fq, bcol0 = u.pn * BM + wc * 32 + 8 * fq;
        f32x4 bv[2][2];
#pragma unroll
        for (int bj = 0; bj < 2; ++bj)
#pragma unroll
            for (int n = 0; n < 2; ++n) bv[bj][n] = bias ? *(const f32x4*)(bias + bcol0 + bj * HALF + 4 * n) : (f32x4){0.f, 0.f, 0.f, 0.f};
#pragma unroll
        for (int ai = 0; ai < 2; ++ai)
#pragma unroll
            for (int m = 0; m < 4; ++m) { bf16_t* rowp = base + (size_t)(row0 + ai * HALF + m * 16) * ldc + col0;
#pragma unroll
                for (int bj = 0; bj < 2; ++bj) { f32x4 v0 = acc[ai][bj][m][0] + bv[bj][0], v1 = acc[ai][bj][m][1] + bv[bj][1];
                    if (ACT == 1) { f32x2 a = gelu_pk((f32x2){v0[0], v0[1]}), b = gelu_pk((f32x2){v0[2], v0[3]}), c = gelu_pk((f32x2){v1[0], v1[1]}), d = gelu_pk((f32x2){v1[2], v1[3]});
                        v0 = (f32x4){a.x, a.y, b.x, b.y}; v1 = (f32x4){c.x, c.y, d.x, d.y}; }
                    v0 = v0 * sc; v1 = v1 * sc; u32x4 w; w.x = cvt_pk_bf16(v0[0], v0[1]); w.y = cvt_pk_bf16(v0[2], v0[3]); w.z = cvt_pk_bf16(v1[0], v1[1]); w.w = cvt_pk_bf16(v1[2], v1[3]);
                    *(u32x4*)(rowp + bj * HALF) = w; } }
    }
};
template <class Epi, class Sched, bool ALIGN_EPI = false, bool SP2 = false>
__device__ __forceinline__ void gemm_phase(PG8_LAS unsigned char* lds, const Gemm g, const Sched& S, const Epi& E) {
    const int tid = threadIdx.x, wid = __builtin_amdgcn_readfirstlane(tid >> 6), lane = tid & 63, wr = wid >> 2, wc = wid & 3, fr = lane & 15, fq = lane >> 4;
    const int K = g.K, nt = K / BK;
    unsigned voffA[2], voffB[2];
#pragma unroll
    for (int i = 0; i < 2; ++i) { int R, C; stage_rc(tid * 16 + i * 8192, R, C); const int Rb = Epi::PERM ? ((R & ~31) + perm32(R & 31)) : R;
        voffA[i] = (unsigned)(R * K + C) * 2u; voffB[i] = (unsigned)(Rb * K + C) * 2u; }
    const size_t kstep = (size_t)(BK * 2);
    const size_t hstep = (size_t)HALF * K * 2;
    const size_t tstep = 2 * hstep;
    const unsigned ldsw = (unsigned)wid * 1024u;
    const int aoff = lds_byte(wr * 64 + fr, fq * 8), boff = lds_byte(wc * 32 + fr, fq * 8);
#define PG8_SA(b, h) (((b) * 2 + (h)) * HTB)
#define PG8_SB(b, h) ((4 + (b) * 2 + (h)) * HTB)
#define PG8_STAGE(bufoff, gbase, voff) do { _Pragma("unroll") for (int _i = 0; _i < 2; ++_i) \
        __builtin_amdgcn_global_load_lds((const unsigned*)((const char*)(gbase) + (voff)[_i]), (PG8_LAS unsigned*)(lds + (bufoff) + ldsw + _i * 8192), 16, 0, 0); } while (0)
#define PG8_LDA(dst, b, h) do { _Pragma("unroll") for (int m = 0; m < 4; ++m) _Pragma("unroll") for (int k = 0; k < 2; ++k) dst[m][k] = *(const PG8_LAS bf16x8*)(lds + PG8_SA(b, h) + aoff + m * 2048 + k * 1024); } while (0)
#define PG8_LDB(dst, b, h) do { _Pragma("unroll") for (int n = 0; n < 2; ++n) _Pragma("unroll") for (int k = 0; k < 2; ++k) dst[n][k] = *(const PG8_LAS bf16x8*)(lds + PG8_SB(b, h) + boff + n * 2048 + k * 1024); } while (0)
#define PG8_MMA(ai, bj, At, Bt) do { __builtin_amdgcn_s_setprio(1); _Pragma("unroll") for (int m = 0; m < 4; ++m) _Pragma("unroll") for (int n = 0; n < 2; ++n) _Pragma("unroll") for (int k = 0; k < 2; ++k) \
        acc[ai][bj][m][n] = __builtin_amdgcn_mfma_f32_16x16x32_bf16(Bt[n][k], At[m][k], acc[ai][bj][m][n], 0, 0, 0); __builtin_amdgcn_s_setprio(0); } while (0)
#define PG8_WAIT_V(n) asm volatile("s_waitcnt vmcnt(" #n ")" ::: "memory")
#define PG8_WAIT_L(n) asm volatile("s_waitcnt lgkmcnt(" #n ")" ::: "memory")
#define PG8_BAR __builtin_amdgcn_s_barrier()
#define PG8_SCHED __builtin_amdgcn_sched_barrier(0)
    Unit cur, nxt; int ui = 0;
    if (!S.next(0, cur)) return;
    f32x4 acc[2][2][4][2];
#pragma unroll
    for (int a = 0; a < 2; ++a)
#pragma unroll
        for (int b = 0; b < 2; ++b)
#pragma unroll
            for (int m = 0; m < 4; ++m)
#pragma unroll
                for (int n = 0; n < 2; ++n) acc[a][b][m][n] = (f32x4){0.f, 0.f, 0.f, 0.f};
    bf16x8 At[4][2], B0[2][2], B1[2][2];
    const char* cA = (const char*)g.A + (size_t)cur.pm * tstep; const char* cB = (const char*)g.Bt + (size_t)cur.pn * tstep;
    S.a_ready(cur);
    if constexpr (SP2) {
        PG8_STAGE(PG8_SB(0, 0), cB, voffB); PG8_STAGE(PG8_SB(0, 1), cB + hstep, voffB); PG8_STAGE(PG8_SA(0, 0), cA, voffA); PG8_STAGE(PG8_SA(0, 1), cA + hstep, voffA);
        if (wr == 1) PG8_BAR;
        PG8_WAIT_V(2); PG8_BAR;
        PG8_STAGE(PG8_SB(1, 0), cB + kstep, voffB); PG8_STAGE(PG8_SA(1, 0), cA + kstep, voffA); PG8_STAGE(PG8_SB(1, 1), cB + hstep + kstep, voffB);
        PG8_WAIT_V(6); PG8_BAR;
    } else {
        PG8_STAGE(PG8_SB(0, 0), cB, voffB); PG8_STAGE(PG8_SA(0, 0), cA, voffA); PG8_STAGE(PG8_SB(0, 1), cB + hstep, voffB); PG8_STAGE(PG8_SA(0, 1), cA + hstep, voffA);
        if (wr == 1) PG8_BAR;
        PG8_WAIT_V(4); PG8_BAR;
        PG8_STAGE(PG8_SB(1, 0), cB + kstep, voffB); PG8_STAGE(PG8_SA(1, 0), cA + kstep, voffA); PG8_STAGE(PG8_SB(1, 1), cB + hstep + kstep, voffB);
        PG8_WAIT_V(6); PG8_BAR;
    }
    for (;;) {
        const bool has_next = S.next(ui + 1, nxt);
        const char* nA = has_next ? (const char*)g.A + (size_t)nxt.pm * tstep : cA; const char* nB = has_next ? (const char*)g.Bt + (size_t)nxt.pn * tstep : cB;
        for (int t = 0; t < nt; t += 2) {
            const bool last = (t == nt - 2);
            const char* a1 = cA + (size_t)(t + 1) * kstep;
            const char* a2 = last ? nA : cA + (size_t)(t + 2) * kstep; const char* b2 = last ? nB : cB + (size_t)(t + 2) * kstep;
            const char* a3 = a2 + kstep; const char* b3 = b2 + kstep;
            if (last && has_next) S.a_ready(nxt);
            if constexpr (SP2) {
            PG8_LDB(B0, 0, 0); PG8_LDB(B1, 0, 1); PG8_SCHED; PG8_LDA(At, 0, 0); PG8_STAGE(PG8_SA(1, 1), a1 + hstep, voffA);
            PG8_WAIT_V(8); PG8_WAIT_L(0); PG8_BAR; PG8_MMA(0, 0, At, B0); PG8_MMA(0, 1, At, B1); PG8_BAR; PG8_SCHED;
            PG8_LDA(At, 0, 1); PG8_STAGE(PG8_SB(0, 0), b2, voffB); PG8_STAGE(PG8_SB(0, 1), b2 + hstep, voffB); PG8_STAGE(PG8_SA(0, 0), a2, voffA);
            PG8_WAIT_V(8); PG8_WAIT_L(0); PG8_BAR; PG8_MMA(1, 0, At, B0); PG8_MMA(1, 1, At, B1); PG8_BAR; PG8_SCHED;
            PG8_LDB(B0, 1, 0); PG8_LDB(B1, 1, 1); PG8_SCHED; PG8_LDA(At, 1, 0); PG8_STAGE(PG8_SA(0, 1), a2 + hstep, voffA);
            PG8_WAIT_V(8); PG8_WAIT_L(0); PG8_BAR; PG8_MMA(0, 0, At, B0); PG8_MMA(0, 1, At, B1); PG8_BAR; PG8_SCHED;
            PG8_LDA(At, 1, 1); PG8_STAGE(PG8_SB(1, 0), b3, voffB); PG8_STAGE(PG8_SB(1, 1), b3 + hstep, voffB); PG8_STAGE(PG8_SA(1, 0), a3, voffA);
            PG8_WAIT_V(8); PG8_WAIT_L(0); PG8_BAR; PG8_MMA(1, 0, At, B0); PG8_MMA(1, 1, At, B1); PG8_BAR; PG8_SCHED;
            } else {
            PG8_LDB(B0, 0, 0); PG8_SCHED; PG8_LDA(At, 0, 0); PG8_STAGE(PG8_SA(1, 1), a1 + hstep, voffA);
            PG8_WAIT_L(8); PG8_BAR; PG8_WAIT_L(0); PG8_MMA(0, 0, At, B0); PG8_BAR; PG8_SCHED;
            PG8_LDB(B1, 0, 1); PG8_STAGE(PG8_SB(0, 0), b2, voffB);
            PG8_BAR; PG8_WAIT_L(0); PG8_MMA(0, 1, At, B1); PG8_BAR;
            PG8_LDA(At, 0, 1); PG8_STAGE(PG8_SA(0, 0), a2, voffA);
            PG8_BAR; PG8_WAIT_L(0); PG8_MMA(1, 0, At, B0); PG8_BAR; PG8_SCHED;
            PG8_STAGE(PG8_SB(0, 1), b2 + hstep, voffB);
            PG8_WAIT_V(6); PG8_BAR; PG8_MMA(1, 1, At, B1); PG8_BAR;
            PG8_LDB(B0, 1, 0); PG8_SCHED; PG8_LDA(At, 1, 0); PG8_STAGE(PG8_SA(0, 1), a2 + hstep, voffA);
            PG8_WAIT_L(8); PG8_BAR; PG8_WAIT_L(0); PG8_MMA(0, 0, At, B0); PG8_BAR; PG8_SCHED;
            PG8_LDB(B1, 1, 1); PG8_STAGE(PG8_SB(1, 0), b3, voffB);
            PG8_BAR; PG8_WAIT_L(0); PG8_MMA(0, 1, At, B1); PG8_BAR;
            PG8_LDA(At, 1, 1); PG8_STAGE(PG8_SA(1, 0), a3, voffA);
            PG8_BAR; PG8_WAIT_L(0); PG8_MMA(1, 0, At, B0); PG8_BAR; PG8_SCHED;
            PG8_STAGE(PG8_SB(1, 1), b3 + hstep, voffB);
            PG8_WAIT_V(6); PG8_BAR; PG8_MMA(1, 1, At, B1); PG8_BAR;
            }
        }
        if constexpr (ALIGN_EPI) { if (wr == 0) PG8_BAR; }
        if constexpr (!Epi::AFTER_DRAIN) { E(acc, cur, wr, wc, fr, fq); S.done(cur); }
        if (!has_next) break;
#pragma unroll
        for (int a = 0; a < 2; ++a)
#pragma unroll
            for (int b = 0; b < 2; ++b)
#pragma unroll
                for (int m = 0; m < 4; ++m)
#pragma unroll
                    for (int n = 0; n < 2; ++n) acc[a][b][m][n] = (f32x4){0.f, 0.f, 0.f, 0.f};
        cur = nxt; cA = nA; cB = nB; ++ui;
        if constexpr (ALIGN_EPI) { if (wr == 1) PG8_BAR; }
    }
    PG8_WAIT_V(0);
    if constexpr (!ALIGN_EPI) { if (wr == 0) PG8_BAR; }
    PG8_BAR;
    if constexpr (Epi::AFTER_DRAIN) { E.fused(acc, cur, wr, wc, fr, fq, lds, wid, lane); S.done(cur); }
#undef PG8_SA
#undef PG8_SB
#undef PG8_STAGE
#undef PG8_LDA
#undef PG8_LDB
#undef PG8_MMA
#undef PG8_WAIT_V
#undef PG8_WAIT_L
#undef PG8_BAR
#undef PG8_SCHED
}
}

constexpr int BATCH = 4, SEQ = 8192, DM = 1024, TOK = BATCH * SEQ;
constexpr int P0W = 2304, P1W = 3072;
constexpr float EPS = 1e-6f, LOG2E = 1.4426950408889634f;
constexpr size_t MiB = 1u << 20;
constexpr size_t WS_WIN0 = 0, WS_WOUT0 = 5 * MiB, WS_WIN1 = 7 * MiB, WS_WOUT1 = 13 * MiB, WS_POOL = 15 * MiB;
constexpr size_t WS_H = 16 * MiB;
constexpr size_t WS_Y = 80 * MiB;
constexpr size_t WS_PROJ = 144 * MiB;
constexpr size_t WS_END = 336 * MiB;
constexpr int LDS_BYTES = 147456;
#ifndef N_LAUNCH_MODE
#define N_LAUNCH_MODE 1
#endif
constexpr int NPHASE = 9;

typedef unsigned short bf16;
typedef short bf16x8 __attribute__((ext_vector_type(8)));
typedef short s16x4 __attribute__((ext_vector_type(4)));
typedef float f32x16 __attribute__((ext_vector_type(16)));
typedef float f32x4 __attribute__((ext_vector_type(4)));
typedef float f32x2 __attribute__((ext_vector_type(2)));
typedef unsigned u32x4 __attribute__((ext_vector_type(4)));
typedef unsigned u32x2 __attribute__((ext_vector_type(2)));
typedef __bf16 bf16x2_t __attribute__((ext_vector_type(2)));

__device__ __forceinline__ float bflo(unsigned u) { return __uint_as_float(u << 16); }
__device__ __forceinline__ float bfhi(unsigned u) { return __uint_as_float(u & 0xffff0000u); }
__device__ __forceinline__ unsigned pk2(float lo, float hi) { f32x2 v = {lo, hi}; bf16x2_t b = __builtin_convertvector(v, bf16x2_t); return __builtin_bit_cast(unsigned, b); }
__device__ __forceinline__ float wave_sum(float v) {
#pragma unroll
    for (int o = 1; o < 64; o <<= 1) v += __shfl_xor(v, o);
    return v;
}
__device__ __forceinline__ float sigm(float x) { return __builtin_amdgcn_rcpf(1.f + __builtin_amdgcn_exp2f(-x * LOG2E)); }
__device__ __forceinline__ float silu(float x) { return x * sigm(x); }
#define LDS_WAIT() asm volatile("s_waitcnt lgkmcnt(0)" ::: "memory")

__device__ __forceinline__ void transpose_item(const float* __restrict__ W, int K, int N, bf16* __restrict__ WT, int row_off, float* scr, int item, int lane) {
    const int nblk = N / 32, kb = item / nblk, nb = item % nblk, k0 = 64 * kb, n0 = 32 * nb;
#pragma unroll 8
    for (int i = 0; i < 32; ++i) { const int kk = 2 * i + (lane >> 5); scr[kk * 33 + (lane & 31)] = W[(size_t)(k0 + kk) * N + n0 + (lane & 31)]; }
    LDS_WAIT();
    const int c = lane & 7;
#pragma unroll
    for (int j = 0; j < 4; ++j) { const int n = (lane >> 3) + 8 * j; const float* s = scr + (8 * c) * 33 + n;
        u32x4 o; o.x = pk2(s[0 * 33], s[1 * 33]); o.y = pk2(s[2 * 33], s[3 * 33]); o.z = pk2(s[4 * 33], s[5 * 33]); o.w = pk2(s[6 * 33], s[7 * 33]);
        *(u32x4*)(WT + (size_t)(row_off + n0 + n) * K + k0 + 8 * c) = o; }
    LDS_WAIT();
}
__device__ __forceinline__ void norm_row_bf16(const float* __restrict__ xrow, const float* __restrict__ g, bf16* __restrict__ orow, int lane) {
    const f32x4* xr = (const f32x4*)xrow + lane; const f32x4* gr = (const f32x4*)g + lane;
    f32x4 v[4]; float s = 0.f;
#pragma unroll
    for (int j = 0; j < 4; ++j) { v[j] = xr[64 * j]; s += (v[j].x * v[j].x + v[j].y * v[j].y) + (v[j].z * v[j].z + v[j].w * v[j].w); }
    const float r = 1.0f / sqrtf(wave_sum(s) * (1.f / DM) + EPS);
    u32x2* o8 = (u32x2*)orow + lane;
#pragma unroll
    for (int j = 0; j < 4; ++j) { const f32x4 gv = gr[64 * j]; u32x2 o; o.x = pk2(v[j].x * r * gv.x, v[j].y * r * gv.y); o.y = pk2(v[j].z * r * gv.z, v[j].w * r * gv.w); o8[64 * j] = o; }
}
__device__ __forceinline__ void resid_row(const float* xrow, const bf16* __restrict__ yrow, const float* __restrict__ gpost, const float* __restrict__ gpre, float* x1row, bf16* __restrict__ hrow, int lane) {
    const u32x2* yr = (const u32x2*)yrow + lane; const f32x4* xr = (const f32x4*)xrow + lane; const f32x4* gp = (const f32x4*)gpost + lane;
    f32x4 y[4]; float s = 0.f;
#pragma unroll
    for (int j = 0; j < 4; ++j) { const u32x2 u = yr[64 * j]; y[j] = (f32x4){bflo(u.x), bfhi(u.x), bflo(u.y), bfhi(u.y)};
        s += (y[j].x * y[j].x + y[j].y * y[j].y) + (y[j].z * y[j].z + y[j].w * y[j].w); }
    const float r = 1.0f / sqrtf(wave_sum(s) * (1.f / DM) + EPS);
    f32x4 x1[4]; float s2 = 0.f;
#pragma unroll
    for (int j = 0; j < 4; ++j) { const f32x4 xv = xr[64 * j]; const f32x4 gv = gp[64 * j]; x1[j] = xv + y[j] * r * gv;
        s2 += (x1[j].x * x1[j].x + x1[j].y * x1[j].y) + (x1[j].z * x1[j].z + x1[j].w * x1[j].w); }
    f32x4* xo = (f32x4*)x1row + lane;
#pragma unroll
    for (int j = 0; j < 4; ++j) xo[64 * j] = x1[j];
    if (hrow) {
        const float r2 = 1.0f / sqrtf(wave_sum(s2) * (1.f / DM) + EPS);
        const f32x4* gq = (const f32x4*)gpre + lane; u32x2* o8 = (u32x2*)hrow + lane;
#pragma unroll
        for (int j = 0; j < 4; ++j) { const f32x4 gv = gq[64 * j]; u32x2 o; o.x = pk2(x1[j].x * r2 * gv.x, x1[j].y * r2 * gv.y); o.y = pk2(x1[j].z * r2 * gv.z, x1[j].w * r2 * gv.w); o8[64 * j] = o; }
    }
}

constexpr int KS_LD = 72, VT_LD = 260, KS_BYTES = 256 * KS_LD * 2;
__device__ __forceinline__ void attn_unit(const bf16* __restrict__ proj, bf16* __restrict__ mix, const float* __restrict__ sinks, unsigned char* lds, int unit, int tid) {
    const int lane = tid & 63, wid = tid >> 6, r32 = lane & 31, hi = lane >> 5;
    const int kvh = unit & 1, n = (unit >> 1) & 63, b = unit >> 7;
    const long tok0 = (long)b * SEQ + n * 128;
    bf16* Ks = (bf16*)lds;
    bf16* Vt = (bf16*)(lds + KS_BYTES);
#pragma unroll
    for (int i = 0; i < 4; ++i) {
        const int id = i * 512 + tid, row = id >> 3, c = id & 7;
        u32x4 kv = {0u, 0u, 0u, 0u}, vv = {0u, 0u, 0u, 0u};
        if (n > 0 || row >= 128) {
            const bf16* src = proj + (tok0 - 128 + row) * P0W;
            kv = *(const u32x4*)(src + 512 + kvh * 64 + c * 8);
            vv = *(const u32x4*)(src + 640 + kvh * 64 + c * 8);
        }
        *(u32x4*)(Ks + row * KS_LD + c * 8) = kv;
        bf16* vd = Vt + (c * 8) * VT_LD + row;
        vd[0 * VT_LD] = (bf16)(vv.x & 0xffffu); vd[1 * VT_LD] = (bf16)(vv.x >> 16);
        vd[2 * VT_LD] = (bf16)(vv.y & 0xffffu); vd[3 * VT_LD] = (bf16)(vv.y >> 16);
        vd[4 * VT_LD] = (bf16)(vv.z & 0xffffu); vd[5 * VT_LD] = (bf16)(vv.z >> 16);
        vd[6 * VT_LD] = (bf16)(vv.w & 0xffffu); vd[7 * VT_LD] = (bf16)(vv.w >> 16);
    }
    __syncthreads();
    const int g = wid >> 1, qh = wid & 1, hq = kvh * 4 + g;
    const float slope2 = __builtin_amdgcn_exp2f(-(float)(hq + 1)) * LOG2E;
    const float sink2 = sinks[hq] * LOG2E;
    const float SC2 = 0.125f * LOG2E;
#pragma unroll 1
    for (int sub = 0; sub < 2; ++sub) {
        const int q0 = qh * 64 + sub * 32;
        const long tok = tok0 + q0 + r32;
        const bf16* qp = proj + tok * P0W + hq * 64 + hi * 8;
        bf16x8 qf[4];
#pragma unroll
        for (int ds = 0; ds < 4; ++ds) qf[ds] = *(const bf16x8*)(qp + ds * 16);
        f32x16 s[5];
#pragma unroll
        for (int kt = 0; kt < 5; ++kt) {
            f32x16 acc = {0.f, 0.f, 0.f, 0.f, 0.f, 0.f, 0.f, 0.f, 0.f, 0.f, 0.f, 0.f, 0.f, 0.f, 0.f, 0.f};
            const bf16* kp = Ks + (q0 + 32 * kt + r32) * KS_LD + hi * 8;
#pragma unroll
            for (int ds = 0; ds < 4; ++ds) acc = __builtin_amdgcn_mfma_f32_32x32x16_bf16(*(const bf16x8*)(kp + ds * 16), qf[ds], acc, 0, 0, 0);
            s[kt] = acc;
            __builtin_amdgcn_sched_barrier(0);
        }
        float mx = sink2;
        {
            int base_i = 128 + r32 - 4 * hi;
            int lo_i = (n > 0) ? (base_i - 128) : max(base_i - 128, 127 - q0 - 4 * hi);
            float sbf = slope2 * (float)base_i;
            asm volatile("" : "+v"(base_i), "+v"(lo_i), "+v"(sbf));
#pragma unroll
            for (int kt = 0; kt < 5; ++kt)
#pragma unroll
                for (int r = 0; r < 16; ++r) {
                    const int cc = 32 * kt + (r & 3) + 8 * (r >> 2);
                    const bool valid = (cc <= base_i) && (cc > lo_i);
                    const float bias = fmaf(slope2, (float)cc, -sbf);
                    const float v = valid ? fmaf(s[kt][r], SC2, bias) : -INFINITY;
                    s[kt][r] = v; mx = fmaxf(mx, v);
                }
        }
        mx = fmaxf(mx, __shfl_xor(mx, 32));
        float sum = 0.f;
#pragma unroll
        for (int kt = 0; kt < 5; ++kt)
#pragma unroll
            for (int r = 0; r < 16; ++r) { const float p = __builtin_amdgcn_exp2f(s[kt][r] - mx); s[kt][r] = p; sum += p; }
        sum += __shfl_xor(sum, 32);
        const float inv = 1.0f / (sum + __builtin_amdgcn_exp2f(sink2 - mx));
        f32x16 ot[2];
#pragma unroll
        for (int dt = 0; dt < 2; ++dt) ot[dt] = (f32x16){0.f, 0.f, 0.f, 0.f, 0.f, 0.f, 0.f, 0.f, 0.f, 0.f, 0.f, 0.f, 0.f, 0.f, 0.f, 0.f};
#pragma unroll
        for (int kt = 0; kt < 5; ++kt)
#pragma unroll
            for (int si = 0; si < 2; ++si) {
                u32x4 pw; pw.x = pk2(s[kt][8 * si + 0], s[kt][8 * si + 1]); pw.y = pk2(s[kt][8 * si + 2], s[kt][8 * si + 3]);
                pw.z = pk2(s[kt][8 * si + 4], s[kt][8 * si + 5]); pw.w = pk2(s[kt][8 * si + 6], s[kt][8 * si + 7]);
                const bf16x8 pf = __builtin_bit_cast(bf16x8, pw);
                const int kb = q0 + 32 * kt + 16 * si + 4 * hi;
#pragma unroll
                for (int dt = 0; dt < 2; ++dt) {
                    const bf16* vp = Vt + (dt * 32 + r32) * VT_LD + kb;
                    const s16x4 lo4 = *(const s16x4*)vp, hi4 = *(const s16x4*)(vp + 8);
                    const bf16x8 vf = {lo4[0], lo4[1], lo4[2], lo4[3], hi4[0], hi4[1], hi4[2], hi4[3]};
                    ot[dt] = __builtin_amdgcn_mfma_f32_32x32x16_bf16(vf, pf, ot[dt], 0, 0, 0);
                }
                __builtin_amdgcn_sched_barrier(0);
            }
        const bf16* gap = proj + tok * P0W + 768 + hq * 64;
        bf16* op = mix + tok * DM + hq * 64;
#pragma unroll
        for (int dt = 0; dt < 2; ++dt)
#pragma unroll
            for (int rg = 0; rg < 4; ++rg) {
                const int d = 32 * dt + 8 * rg + 4 * hi;
                const u32x2 gu = *(const u32x2*)(gap + d);
                u32x2 o;
                o.x = pk2(ot[dt][4 * rg + 0] * inv * silu(bflo(gu.x)), ot[dt][4 * rg + 1] * inv * silu(bfhi(gu.x)));
                o.y = pk2(ot[dt][4 * rg + 2] * inv * silu(bflo(gu.y)), ot[dt][4 * rg + 3] * inv * silu(bfhi(gu.y)));
                *(u32x2*)(op + d) = o;
            }
    }
    __syncthreads();
}

constexpr int U_LD = 128, PL_LD = 136, U_BYTES = 144 * U_LD * 2;
__device__ __forceinline__ void pool_unit(const bf16* __restrict__ proj, bf16* __restrict__ mix, const bf16* __restrict__ poolT, const float* __restrict__ pscale, unsigned char* lds, int unit, int tid) {
    const int lane = tid & 63, wid = tid >> 6, r32 = lane & 31, hi = lane >> 5;
    const int g = unit & 3, n = (unit >> 2) & 63, b = unit >> 8;
    const long tok0 = (long)b * SEQ + n * 128;
    bf16* U = (bf16*)lds;
    bf16* Pl = (bf16*)(lds + U_BYTES);
    for (int id = tid; id < 144 * 16; id += 512) {
        const int row = id >> 4, c = id & 15;
        u32x4 v = {0u, 0u, 0u, 0u};
        if (n > 0 || row >= 16) v = *(const u32x4*)(proj + (tok0 - 16 + row) * P0W + 1280 + g * 128 + c * 8);
        *(u32x4*)(U + row * U_LD + c * 8) = v;
    }
    __syncthreads();
    {
        const int cp = tid & 63, tg = tid >> 6, w = 2 << g;
#pragma unroll 1
        for (int tt = 0; tt < 16; ++tt) {
            const int t = tg * 16 + tt;
            float s0 = 0.f, s1 = 0.f;
            for (int i = 0; i < w; ++i) { const unsigned u = *(const unsigned*)(U + (16 + t - i) * U_LD + 2 * cp); s0 += bflo(u); s1 += bfhi(u); }
            const unsigned uc = *(const unsigned*)(U + (16 + t) * U_LD + 2 * cp);
            const int pos = n * 128 + t; const int cnt = (pos + 1 < w) ? (pos + 1) : w; const float ic = 1.0f / (float)cnt;
            *(unsigned*)(Pl + t * PL_LD + 2 * cp) = pk2(s0 * ic - bflo(uc), s1 * ic - bfhi(uc));
        }
    }
    __syncthreads();
    const int tt = wid >> 1, dbase = (wid & 1) * 64;
    const long tok = tok0 + tt * 32 + r32;
#pragma unroll
    for (int dti = 0; dti < 2; ++dti) {
        const int dt0 = dbase + dti * 32;
        f32x16 acc = {0.f, 0.f, 0.f, 0.f, 0.f, 0.f, 0.f, 0.f, 0.f, 0.f, 0.f, 0.f, 0.f, 0.f, 0.f, 0.f};
        const bf16* ap = poolT + (size_t)(g * 128 + dt0 + r32) * 128 + hi * 8;
        const bf16* bp = Pl + (tt * 32 + r32) * PL_LD + hi * 8;
#pragma unroll
        for (int ks = 0; ks < 8; ++ks) acc = __builtin_amdgcn_mfma_f32_32x32x16_bf16(*(const bf16x8*)(ap + ks * 16), *(const bf16x8*)(bp + ks * 16), acc, 0, 0, 0);
        const bf16* gbp = proj + tok * P0W + 1792 + g * 128 + dt0;
        bf16* op = mix + tok * DM + 512 + g * 128 + dt0;
        const float* scp = pscale + g * 128 + dt0;
#pragma unroll
        for (int rg = 0; rg < 4; ++rg) {
            const int d = 8 * rg + 4 * hi;
            const u32x2 gu = *(const u32x2*)(gbp + d);
            const f32x4 sc = *(const f32x4*)(scp + d);
            u32x2 o;
            o.x = pk2(acc[4 * rg + 0] * sc.x * silu(bflo(gu.x)), acc[4 * rg + 1] * sc.y * silu(bfhi(gu.x)));
            o.y = pk2(acc[4 * rg + 2] * sc.z * silu(bflo(gu.y)), acc[4 * rg + 3] * sc.w * silu(bfhi(gu.y)));
            *(u32x2*)(op + d) = o;
        }
    }
    __syncthreads();
}

namespace pg8 {
struct EpiGlu {
    static constexpr bool PERM = true, AFTER_DRAIN = false;
    bf16_t* O;
    __device__ __forceinline__ void operator()(const f32x4 (&acc)[2][2][4][2], const Unit& u, int wr, int wc, int fr, int fq) const {
        const int row0 = u.pm * BM + wr * 64 + fr;
        if (u.pn < 8) {
            const int col0 = u.pn * 128 + wc * 32 + 8 * fq;
#pragma unroll
            for (int ai = 0; ai < 2; ++ai)
#pragma unroll
                for (int m = 0; m < 4; ++m) {
                    bf16_t* rowp = O + (size_t)(row0 + ai * HALF + m * 16) * 2048 + col0;
                    const f32x4 a0 = acc[ai][0][m][0], a1 = acc[ai][0][m][1], b0 = acc[ai][1][m][0], b1 = acc[ai][1][m][1];
                    u32x4 w;
                    w.x = ::pk2(a0[0] * ::sigm(b0[0]), a0[1] * ::sigm(b0[1])); w.y = ::pk2(a0[2] * ::sigm(b0[2]), a0[3] * ::sigm(b0[3]));
                    w.z = ::pk2(a1[0] * ::sigm(b1[0]), a1[1] * ::sigm(b1[1])); w.w = ::pk2(a1[2] * ::sigm(b1[2]), a1[3] * ::sigm(b1[3]));
                    *(u32x4*)rowp = w;
                }
        } else {
            const int col0 = 1024 + (u.pn - 8) * 256 + wc * 32 + 8 * fq;
#pragma unroll
            for (int ai = 0; ai < 2; ++ai)
#pragma unroll
                for (int m = 0; m < 4; ++m) {
                    bf16_t* rowp = O + (size_t)(row0 + ai * HALF + m * 16) * 2048 + col0;
#pragma unroll
                    for (int bj = 0; bj < 2; ++bj) {
                        const f32x4 v0 = acc[ai][bj][m][0], v1 = acc[ai][bj][m][1];
                        u32x4 w;
                        w.x = ::pk2(::silu(v0[0]), ::silu(v0[1])); w.y = ::pk2(::silu(v0[2]), ::silu(v0[3]));
                        w.z = ::pk2(::silu(v1[0]), ::silu(v1[1])); w.w = ::pk2(::silu(v1[2]), ::silu(v1[3]));
                        *(u32x4*)(rowp + bj * HALF) = w;
                    }
                }
        }
    }
};
}

constexpr int GLW = 2048;
__device__ __forceinline__ void conv_phase(const bf16* __restrict__ gl, bf16* __restrict__ z, const float* __restrict__ dww, const float* __restrict__ dwb,
                                          const float* __restrict__ lng, const float* __restrict__ lnb, unsigned char* lds, int bid, int G, int tid) {
    const int lane = tid & 63, wid = tid >> 6;
    float* red = (float*)lds;
    float* stat = (float*)(lds + 1024);
    const int c0 = 2 * tid;
    float w0[31], w1[31];
#pragma unroll
    for (int k = 0; k < 31; ++k) { const f32x2* wp = (const f32x2*)(dww + k * 1024); const f32x2 w = wp[tid]; w0[k] = w.x; w1[k] = w.y; }
#pragma unroll 1
    for (int unit = bid; unit < TOK / 16; unit += G) {
    const long tok0 = (long)unit * 16; const int p0 = (int)(tok0 & (SEQ - 1));
    const unsigned* gbase = (const unsigned*)(gl + tok0 * GLW) + tid;
    unsigned* zbase = (unsigned*)(z + tok0 * DM) + tid;
    asm volatile("" : "+v"(gbase), "+v"(zbase));
    float acc0[16], acc1[16];
    { const f32x2 bb = *(const f32x2*)(dwb + c0);
#pragma unroll
      for (int t = 0; t < 16; ++t) { acc0[t] = bb.x; acc1[t] = bb.y; } }
#pragma unroll
    for (int j = 0; j < 46; ++j) {
        float x0 = 0.f, x1 = 0.f;
        if (p0 + j >= 30) { const unsigned u = gbase[(j - 30) * (GLW / 2)]; x0 = bflo(u); x1 = bfhi(u); }
#pragma unroll
        for (int t = 0; t < 16; ++t) { const int k = j - t; if (k >= 0 && k <= 30) { acc0[t] = fmaf(x0, w0[k], acc0[t]); acc1[t] = fmaf(x1, w1[k], acc1[t]); } }
        if ((j & 7) == 7) __builtin_amdgcn_sched_barrier(0);
    }
    {
        float v[32];
#pragma unroll
        for (int t = 0; t < 16; ++t) { const float a0 = acc0[t], a1 = acc1[t]; v[2 * t] = a0 + a1; v[2 * t + 1] = a0 * a0 + a1 * a1; }
#pragma unroll
        for (int step = 0; step < 5; ++step) {
            const int half = 16 >> step; const bool up = (lane >> step) & 1;
#pragma unroll
            for (int i = 0; i < half; ++i) { const float va = v[i], vb = v[i + half]; const float send = up ? va : vb; const float keep = up ? vb : va; v[i] = keep + __shfl_xor(send, 1 << step); }
        }
        v[0] += __shfl_xor(v[0], 32);
        const int idx = ((lane & 1) << 4) | ((lane & 2) << 2) | (lane & 4) | ((lane & 8) >> 2) | ((lane & 16) >> 4);
        if (lane < 32) red[wid * 32 + idx] = v[0];
    }
    __syncthreads();
    if (tid < 16) {
        float s1 = 0.f, s2 = 0.f;
#pragma unroll
        for (int w = 0; w < 8; ++w) { s1 += red[w * 32 + 2 * tid]; s2 += red[w * 32 + 2 * tid + 1]; }
        const float mu = s1 * (1.f / 1024.f); float var = s2 * (1.f / 1024.f) - mu * mu; var = var > 0.f ? var : 0.f;
        stat[2 * tid] = mu; stat[2 * tid + 1] = 1.0f / sqrtf(var + EPS);
    }
    __syncthreads();
    const f32x2 gg = *(const f32x2*)(lng + c0), bb2 = *(const f32x2*)(lnb + c0);
#pragma unroll
    for (int t = 0; t < 16; ++t) {
        const float mu = stat[2 * t], rs = stat[2 * t + 1];
        const float cn0 = (acc0[t] - mu) * rs * gg.x + bb2.x, cn1 = (acc1[t] - mu) * rs * gg.y + bb2.y;
        const unsigned ug = gbase[t * (GLW / 2) + 512];
        zbase[t * (DM / 2)] = pk2(silu(cn0) * bflo(ug), silu(cn1) * bfhi(ug));
        if ((t & 3) == 3) __builtin_amdgcn_sched_barrier(0);
    }
    __syncthreads();
    }
}

struct Args { const float* in[14]; float* out; unsigned char* ws; int ph_lo, ph_hi; };
__global__ void __launch_bounds__(512, 2) fwd_kernel(Args a) {
    extern __shared__ __attribute__((aligned(16))) unsigned char lds[];
    cg::grid_group grid = cg::this_grid();
    const int tid = threadIdx.x, lane = tid & 63, wid = __builtin_amdgcn_readfirstlane(tid >> 6);
    const int G = gridDim.x, bid = blockIdx.x;
    const int gw = bid * 8 + wid, NGW = G * 8;
    const int lo = a.ph_lo, hi = a.ph_hi;
    unsigned char* ws = a.ws;
    const float* x = a.in[0]; const float* pre_norm = a.in[1]; const float* post_norm = a.in[2];
    bf16* Win0 = (bf16*)(ws + WS_WIN0); bf16* Wout0 = (bf16*)(ws + WS_WOUT0); bf16* Win1 = (bf16*)(ws + WS_WIN1); bf16* Wout1 = (bf16*)(ws + WS_WOUT1); bf16* PoolT = (bf16*)(ws + WS_POOL);
    bf16* Hb = (bf16*)(ws + WS_H); bf16* Yb = (bf16*)(ws + WS_Y); bf16* Pb = (bf16*)(ws + WS_PROJ);
    PG8_LAS unsigned char* lds3 = (PG8_LAS unsigned char*)lds;
#define IN(k) (lo <= (k) && (k) < hi)
#define SEAM(k) do { if (IN(k) && IN((k) + 1)) grid.sync(); } while (0)

    if (IN(0)) {
        float* scr = (float*)(lds + wid * 16384);
        constexpr int I_IN0 = 16 * 72, I_OUT = 16 * 32, I_IN1 = 16 * 96, I_POOL = 32;
        constexpr int NITEMS = I_IN0 + I_OUT + I_IN1 + I_OUT + I_POOL;
        for (int it = gw; it < NITEMS; it += NGW) {
            int r = it;
            if (r < I_IN0) { transpose_item(a.in[3], 1024, P0W, Win0, 0, scr, r, lane); continue; } r -= I_IN0;
            if (r < I_OUT) { transpose_item(a.in[7], 1024, 1024, Wout0, 0, scr, r, lane); continue; } r -= I_OUT;
            if (r < I_IN1) { const int n0 = 32 * (r % 96);
                const int d0 = (n0 < 2048) ? (((n0 & 1023) >> 7) * 256 + (n0 >> 10) * 128 + (n0 & 127)) : n0;
                transpose_item(a.in[8], 1024, P1W, Win1, d0 - n0, scr, r, lane); continue; } r -= I_IN1;
            if (r < I_OUT) { transpose_item(a.in[13], 1024, 1024, Wout1, 0, scr, r, lane); continue; } r -= I_OUT;
            { const int gi = r >> 3; transpose_item(a.in[5] + gi * 16384, 128, 128, PoolT + gi * 16384, 0, scr, r & 7, lane); }
        }
        for (int m = gw; m < TOK; m += NGW) norm_row_bf16(x + (size_t)m * DM, pre_norm, Hb + (size_t)m * DM, lane);
    }
    SEAM(0);
    if (IN(1)) {
        pg8::Gemm g{Hb, Win0, TOK, P0W, DM}; pg8::StaticOrder S; S.init(TOK, P0W, G, bid);
        pg8::EpiBf16<0> E{Pb, P0W, nullptr, 0, 0, 1.f};
        pg8::gemm_phase<pg8::EpiBf16<0>, pg8::StaticOrder, true, true>(lds3, g, S, E);
    }
    SEAM(1);
    if (IN(2)) {
        __syncthreads();
#ifndef SKIP_ATTN
        for (int u = bid; u < 512; u += G) attn_unit(Pb, Hb, a.in[4], lds, u, tid);
#endif
#ifndef SKIP_POOL
        for (int u = bid; u < 1024; u += G) pool_unit(Pb, Hb, PoolT, a.in[6], lds, u, tid);
#endif
    }
    SEAM(2);
    if (IN(3)) {
        pg8::Gemm g{Hb, Wout0, TOK, DM, DM}; pg8::StaticOrder S; S.init(TOK, DM, G, bid);
        pg8::EpiBf16<0> E{Yb, DM, nullptr, 0, 0, 1.f};
        pg8::gemm_phase<pg8::EpiBf16<0>, pg8::StaticOrder, true, true>(lds3, g, S, E);
    }
    SEAM(3);
    if (IN(4)) {
        for (int m = gw; m < TOK; m += NGW) resid_row(x + (size_t)m * DM, Yb + (size_t)m * DM, post_norm, pre_norm + DM, a.out + (size_t)m * DM, Hb + (size_t)m * DM, lane);
    }
    SEAM(4);
    if (IN(5)) {
        pg8::Gemm g{Hb, Win1, TOK, P1W, DM}; pg8::StaticOrder S; S.init(TOK, P1W, G, bid);
        pg8::EpiGlu E{Pb};
        pg8::gemm_phase<pg8::EpiGlu, pg8::StaticOrder, true, true>(lds3, g, S, E);
    }
    SEAM(5);
    if (IN(6)) {
        __syncthreads();
#ifndef SKIP_CONV
        conv_phase(Pb, Hb, a.in[9], a.in[10], a.in[11], a.in[12], lds, bid, G, tid);
#endif
    }
    SEAM(6);
    if (IN(7)) {
        pg8::Gemm g{Hb, Wout1, TOK, DM, DM}; pg8::StaticOrder S; S.init(TOK, DM, G, bid);
        pg8::EpiBf16<0> E{Yb, DM, nullptr, 0, 0, 1.f};
        pg8::gemm_phase<pg8::EpiBf16<0>, pg8::StaticOrder, true, true>(lds3, g, S, E);
    }
    SEAM(7);
    if (IN(8)) {
        for (int m = gw; m < TOK; m += NGW) resid_row(a.out + (size_t)m * DM, Yb + (size_t)m * DM, post_norm + DM, nullptr, a.out + (size_t)m * DM, nullptr, lane);
    }
#undef IN
#undef SEAM
}

extern "C" void kernel_launch(void* const* d_in, const int* in_sizes, int n_in, void* d_out, int out_size, void* d_ws, size_t ws_size, hipStream_t stream) {
    static int grid = 0;
    if (grid == 0) {
        if (n_in != 14 || out_size != TOK * DM || ws_size < WS_END) { fprintf(stderr, "kernel_launch: unexpected shapes (n_in %d, out %d, ws %zu)\n", n_in, out_size, ws_size); grid = -1; return; }
        int dev = 0, cus = 0, per_cu = 0;
        hipGetDevice(&dev);
        hipDeviceGetAttribute(&cus, hipDeviceAttributeMultiprocessorCount, dev);
        if (hipFuncSetAttribute((const void*)fwd_kernel, hipFuncAttributeMaxDynamicSharedMemorySize, LDS_BYTES) != hipSuccess) { fprintf(stderr, "kernel_launch: hipFuncSetAttribute failed\n"); grid = -1; return; }
        if (hipOccupancyMaxActiveBlocksPerMultiprocessor(&per_cu, (const void*)fwd_kernel, 512, LDS_BYTES) != hipSuccess || per_cu < 1) { fprintf(stderr, "kernel_launch: occupancy query says %d\n", per_cu); per_cu = 1; }
        (void)hipGetLastError();
        grid = cus * 1;
        if (grid <= 0) grid = 256;
    }
    if (grid < 0) return;
    Args a{};
    for (int i = 0; i < 14; ++i) a.in[i] = (const float*)d_in[i];
    a.out = (float*)d_out; a.ws = (unsigned char*)d_ws;
#if N_LAUNCH_MODE == 1
    a.ph_lo = 0; a.ph_hi = NPHASE;
    void* args[] = {&a};
    hipError_t e = hipLaunchCooperativeKernel((const void*)fwd_kernel, dim3(grid), dim3(512), args, LDS_BYTES, stream);
    if (e != hipSuccess) fprintf(stderr, "cooperative launch failed: %s (grid %d)\n", hipGetErrorString(e), grid);
#else
    for (int p = 0; p < NPHASE; ++p) {
        a.ph_lo = p; a.ph_hi = p + 1;
        hipLaunchKernelGGL(fwd_kernel, dim3(grid), dim3(512), LDS_BYTES, stream, a);
    }
#endif
}
```

```cpp
#include <hip/hip_runtime.h>
#include <hip/hip_cooperative_groups.h>
#include <cstdio>
#include <cstdint>
namespace cg = cooperative_groups;
#define N_LAUNCH_MODE 1
namespace pg8 {
#define PG8_LAS __attribute__((address_space(3)))
typedef unsigned short bf16_t;
typedef short bf16x8 __attribute__((ext_vector_type(8)));
typedef float f32x4 __attribute__((ext_vector_type(4)));
typedef unsigned u32x4 __attribute__((ext_vector_type(4)));
constexpr int BM = 256, BK = 64, HALF = 128, HTB = HALF * BK * 2  , STAGE_BYTES = 8 * HTB, NXCD = 8, WGM = 8;

__host__ __device__ __forceinline__ int lds_byte(int r, int c) { const int st = (r >> 4) * 2 + (c >> 5), rr = r & 15, cc = c & 31, ob = rr * 64 + cc * 2; return st * 1024 + (ob ^ (((ob >> 9) & 1) << 5)); }
__host__ __device__ __forceinline__ void stage_rc(int b, int& R, int& C) { const int st = b / 1024, sb = b % 1024, swz = sb ^ (((sb >> 9) & 1) << 5); R = (st >> 1) * 16 + swz / 64; C = (st & 1) * 32 + (swz % 64) / 2; }
__host__ __device__ __forceinline__ int perm32(int rho) { const int n = rho >> 4, i = rho & 15; return 8 * (i >> 2) + 4 * n + (i & 3); }

struct Unit { int pm, pn; };
struct Gemm { const bf16_t* A; const bf16_t* Bt; int M, N, K; };

struct StaticOrder {
    int nM, nN, nwg, G, c;
    __host__ __device__ void init(int M, int N, int G_, int c_) { nM = M / BM; nN = N / BM; nwg = nM * nN; G = G_; c = c_; }
    __host__ __device__ bool next(int i, Unit& u) const {
        const long L = (long)i * G + c; if (L >= nwg) return false;
        int wgid = (int)L; { const int q = nwg / NXCD, r = nwg % NXCD, xcd = wgid % NXCD, off = wgid / NXCD; wgid = (xcd < r ? xcd * (q + 1) : r * (q + 1) + (xcd - r) * q) + off; }
        const int nig = WGM * nN, gid = wgid / nig, fm = gid * WGM, gsz = (nM - fm) < WGM ? (nM - fm) : WGM;
        u.pm = fm + ((wgid % nig) % gsz); u.pn = (wgid % nig) / gsz; return true;
    }
    __device__ __forceinline__ void a_ready(const Unit&) const {}
    __device__ __forceinline__ void done(const Unit&) const {}
};

__device__ __forceinline__ unsigned cvt_pk_bf16(float lo, float hi) { unsigned r; asm volatile("v_cvt_pk_bf16_f32 %0, %1, %2" : "=v"(r) : "v"(lo), "v"(hi)); return r; }
typedef float f32x2 __attribute__((ext_vector_type(2)));
__device__ __forceinline__ f32x2 gelu_pk(f32x2 v) {
    const f32x2 av = __builtin_elementwise_abs(v), d = av * 0.2316418882f + 1.0f;
    f32x2 t; t.x = __builtin_amdgcn_rcpf(d.x); t.y = __builtin_amdgcn_rcpf(d.y);
    f32x2 q = t * 0.5307027145f + (-0.7265760135f); q = q * t + 0.7107068705f; q = q * t + (-0.142248368f); q = q * t + 0.127414796f; q = q * t;
    const f32x2 s = (v * v) * (-0.72134752044f);
    f32x2 e; e.x = __builtin_amdgcn_exp2f(s.x); e.y = __builtin_amdgcn_exp2f(s.y);
    const f32x2 m = v * (q * e), r = v - m;
    f32x2 o; o.x = v.x < 0.f ? m.x : r.x; o.y = v.y < 0.f ? m.y : r.y; return o;
}

template <int ACT  > struct EpiBf16 {
    static constexpr bool PERM = true, AFTER_DRAIN = false; static_assert(ACT == 0 || ACT == 1, "EpiBf16: ACT is 0 (none) or 1 (gelu_pk)");
    bf16_t* O; int ldc; const float* bias; int split_cols; size_t split_stride; float scale0;
    __device__ __forceinline__ void operator()(const f32x4 (&acc)[2][2][4][2], const Unit& u, int wr, int wc, int fr, int fq) const {
        const int row0 = u.pm * BM + wr * 64 + fr; int colt = u.pn * BM; bf16_t* base = O;
        float sc = 1.f; if (split_cols) { const int t = colt / split_cols; base += (size_t)t * split_stride; colt -= t * split_cols; if (t == 0) sc = scale0; }
        const int col0 = colt + wc * 32 + 8 * fq, bcol0 = u.pn * BM + wc * 32 + 8 * fq;
        f32x4 bv[2][2];
#pragma unroll
        for (int bj = 0; bj < 2; ++bj)
#pragma unroll
            for (int n = 0; n < 2; ++n) bv[bj][n] = bias ? *(const f32x4*)(bias + bcol0 + bj * HALF + 4 * n) : (f32x4){0.f, 0.f, 0.f, 0.f};
#pragma unroll
        for (int ai = 0; ai < 2; ++ai)
#pragma unroll
            for (int m = 0; m < 4; ++m) { bf16_t* rowp = base + (size_t)(row0 + ai * HALF + m * 16) * ldc + col0;
#pragma unroll
                for (int bj = 0; bj < 2; ++bj) { f32x4 v0 = acc[ai][bj][m][0] + bv[bj][0], v1 = acc[ai][bj][m][1] + bv[bj][1];
                    if (ACT == 1) { f32x2 a = gelu_pk((f32x2){v0[0], v0[1]}), b = gelu_pk((f32x2){v0[2], v0[3]}), c = gelu_pk((f32x2){v1[0], v1[1]}), d = gelu_pk((f32x2){v1[2], v1[3]});
                        v0 = (f32x4){a.x, a.y, b.x, b.y}; v1 = (f32x4){c.x, c.y, d.x, d.y}; }
                    v0 = v0 * sc; v1 = v1 * sc; u32x4 w; w.x = cvt_pk_bf16(v0[0], v0[1]); w.y = cvt_pk_bf16(v0[2], v0[3]); w.z = cvt_pk_bf16(v1[0], v1[1]); w.w = cvt_pk_bf16(v1[2], v1[3]);
                    *(u32x4*)(rowp + bj * HALF) = w; } }
    }
};
template <class Epi, class Sched, bool ALIGN_EPI = false, bool SP2 = false>
__device__ __forceinline__ void gemm_phase(PG8_LAS unsigned char* lds, const Gemm g, const Sched& S, const Epi& E) {
    const int tid = threadIdx.x, wid = __builtin_amdgcn_readfirstlane(tid >> 6), lane = tid & 63, wr = wid >> 2, wc = wid & 3, fr = lane & 15, fq = lane >> 4;
    const int K = g.K, nt = K / BK;
    unsigned voffA[2], voffB[2];
#pragma unroll
    for (int i = 0; i < 2; ++i) { int R, C; stage_rc(tid * 16 + i * 8192, R, C); const int Rb = Epi::PERM ? ((R & ~31) + perm32(R & 31)) : R;
        voffA[i] = (unsigned)(R * K + C) * 2u; voffB[i] = (unsigned)(Rb * K + C) * 2u; }
    const size_t kstep = (size_t)(BK * 2);
    const size_t hstep = (size_t)HALF * K * 2;
    const size_t tstep = 2 * hstep;
    const unsigned ldsw = (unsigned)wid * 1024u;
    const int aoff = lds_byte(wr * 64 + fr, fq * 8), boff = lds_byte(wc * 32 + fr, fq * 8);
#define PG8_SA(b, h) (((b) * 2 + (h)) * HTB)
#define PG8_SB(b, h) ((4 + (b) * 2 + (h)) * HTB)
#define PG8_STAGE(bufoff, gbase, voff) do { _Pragma("unroll") for (int _i = 0; _i < 2; ++_i) \
        __builtin_amdgcn_global_load_lds((const unsigned*)((const char*)(gbase) + (voff)[_i]), (PG8_LAS unsigned*)(lds + (bufoff) + ldsw + _i * 8192), 16, 0, 0); } while (0)
#define PG8_LDA(dst, b, h) do { _Pragma("unroll") for (int m = 0; m < 4; ++m) _Pragma("unroll") for (int k = 0; k < 2; ++k) dst[m][k] = *(const PG8_LAS bf16x8*)(lds + PG8_SA(b, h) + aoff + m * 2048 + k * 1024); } while (0)
#define PG8_LDB(dst, b, h) do { _Pragma("unroll") for (int n = 0; n < 2; ++n) _Pragma("unroll") for (int k = 0; k < 2; ++k) dst[n][k] = *(const PG8_LAS bf16x8*)(lds + PG8_SB(b, h) + boff + n * 2048 + k * 1024); } while (0)
#define PG8_MMA(ai, bj, At, Bt) do { __builtin_amdgcn_s_setprio(1); _Pragma("unroll") for (int m = 0; m < 4; ++m) _Pragma("unroll") for (int n = 0; n < 2; ++n) _Pragma("unroll") for (int k = 0; k < 2; ++k) \
        acc[ai][bj][m][n] = __builtin_amdgcn_mfma_f32_16x16x32_bf16(Bt[n][k], At[m][k], acc[ai][bj][m][n], 0, 0, 0); __builtin_amdgcn_s_setprio(0); } while (0)
#define PG8_WAIT_V(n) asm volatile("s_waitcnt vmcnt(" #n ")" ::: "memory")
#define PG8_WAIT_L(n) asm volatile("s_waitcnt lgkmcnt(" #n ")" ::: "memory")
#define PG8_BAR __builtin_amdgcn_s_barrier()
#define PG8_SCHED __builtin_amdgcn_sched_barrier(0)
    Unit cur, nxt; int ui = 0;
    if (!S.next(0, cur)) return;
    f32x4 acc[2][2][4][2];
#pragma unroll
    for (int a = 0; a < 2; ++a)
#pragma unroll
        for (int b = 0; b < 2; ++b)
#pragma unroll
            for (int m = 0; m < 4; ++m)
#pragma unroll
                for (int n = 0; n < 2; ++n) acc[a][b][m][n] = (f32x4){0.f, 0.f, 0.f, 0.f};
    bf16x8 At[4][2], B0[2][2], B1[2][2];
    const char* cA = (const char*)g.A + (size_t)cur.pm * tstep; const char* cB = (const char*)g.Bt + (size_t)cur.pn * tstep;
    S.a_ready(cur);
    if constexpr (SP2) {
        PG8_STAGE(PG8_SB(0, 0), cB, voffB); PG8_STAGE(PG8_SB(0, 1), cB + hstep, voffB); PG8_STAGE(PG8_SA(0, 0), cA, voffA); PG8_STAGE(PG8_SA(0, 1), cA + hstep, voffA);
        if (wr == 1) PG8_BAR;
        PG8_WAIT_V(2); PG8_BAR;
        PG8_STAGE(PG8_SB(1, 0), cB + kstep, voffB); PG8_STAGE(PG8_SA(1, 0), cA + kstep, voffA); PG8_STAGE(PG8_SB(1, 1), cB + hstep + kstep, voffB);
        PG8_WAIT_V(6); PG8_BAR;
    } else {
        PG8_STAGE(PG8_SB(0, 0), cB, voffB); PG8_STAGE(PG8_SA(0, 0), cA, voffA); PG8_STAGE(PG8_SB(0, 1), cB + hstep, voffB); PG8_STAGE(PG8_SA(0, 1), cA + hstep, voffA);
        if (wr == 1) PG8_BAR;
        PG8_WAIT_V(4); PG8_BAR;
        PG8_STAGE(PG8_SB(1, 0), cB + kstep, voffB); PG8_STAGE(PG8_SA(1, 0), cA + kstep, voffA); PG8_STAGE(PG8_SB(1, 1), cB + hstep + kstep, voffB);
        PG8_WAIT_V(6); PG8_BAR;
    }
    for (;;) {
        const bool has_next = S.next(ui + 1, nxt);
        const char* nA = has_next ? (const char*)g.A + (size_t)nxt.pm * tstep : cA; const char* nB = has_next ? (const char*)g.Bt + (size_t)nxt.pn * tstep : cB;
        for (int t = 0; t < nt; t += 2) {
            const bool last = (t == nt - 2);
            const char* a1 = cA + (size_t)(t + 1) * kstep;
            const char* a2 = last ? nA : cA + (size_t)(t + 2) * kstep; const char* b2 = last ? nB : cB + (size_t)(t + 2) * kstep;
            const char* a3 = a2 + kstep; const char* b3 = b2 + kstep;
            if (last && has_next) S.a_ready(nxt);
            if constexpr (SP2) {
            PG8_LDB(B0, 0, 0); PG8_LDB(B1, 0, 1); PG8_SCHED; PG8_LDA(At, 0, 0); PG8_STAGE(PG8_SA(1, 1), a1 + hstep, voffA);
            PG8_WAIT_V(8); PG8_WAIT_L(0); PG8_BAR; PG8_MMA(0, 0, At, B0); PG8_MMA(0, 1, At, B1); PG8_BAR; PG8_SCHED;
            PG8_LDA(At, 0, 1); PG8_STAGE(PG8_SB(0, 0), b2, voffB); PG8_STAGE(PG8_SB(0, 1), b2 + hstep, voffB); PG8_STAGE(PG8_SA(0, 0), a2, voffA);
            PG8_WAIT_V(8); PG8_WAIT_L(0); PG8_BAR; PG8_MMA(1, 0, At, B0); PG8_MMA(1, 1, At, B1); PG8_BAR; PG8_SCHED;
            PG8_LDB(B0, 1, 0); PG8_LDB(B1, 1, 1); PG8_SCHED; PG8_LDA(At, 1, 0); PG8_STAGE(PG8_SA(0, 1), a2 + hstep, voffA);
            PG8_WAIT_V(8); PG8_WAIT_L(0); PG8_BAR; PG8_MMA(0, 0, At, B0); PG8_MMA(0, 1, At, B1); PG8_BAR; PG8_SCHED;
            PG8_LDA(At, 1, 1); PG8_STAGE(PG8_SB(1, 0), b3, voffB); PG8_STAGE(PG8_SB(1, 1), b3 + hstep, voffB); PG8_STAGE(PG8_SA(1, 0), a3, voffA);
            PG8_WAIT_V(8); PG8_WAIT_L(0); PG8_BAR; PG8_MMA(1, 0, At, B0); PG8_MMA(1, 1, At, B1); PG8_BAR; PG8_SCHED;
            } else {
            PG8_LDB(B0, 0, 0); PG8_SCHED; PG8_LDA(At, 0, 0); PG8_STAGE(PG8_SA(1, 1), a1 + hstep, voffA);
            PG8_WAIT_L(8); PG8_BAR; PG8_WAIT_L(0); PG8_MMA(0, 0, At, B0); PG8_BAR; PG8_SCHED;
            PG8_LDB(B1, 0, 1); PG8_STAGE(PG8_SB(0, 0), b2, voffB);
            PG8_BAR; PG8_WAIT_L(0); PG8_MMA(0, 1, At, B1); PG8_BAR;
            PG8_LDA(At, 0, 1); PG8_STAGE(PG8_SA(0, 0), a2, voffA);
            PG8_BAR; PG8_WAIT_L(0); PG8_MMA(1, 0, At, B0); PG8_BAR; PG8_SCHED;
            PG8_STAGE(PG8_SB(0, 1), b2 + hstep, voffB);
            PG8_WAIT_V(6); PG8_BAR; PG8_MMA(1, 1, At, B1); PG8_BAR;
            PG8_LDB(B0, 1, 0); PG8_SCHED; PG8_LDA(At, 1, 0); PG8_STAGE(PG8_SA(0, 1), a2 + hstep, voffA);
            PG8_WAIT_L(8); PG8_BAR; PG8_WAIT_L(0); PG8_MMA(0, 0, At, B0); PG8_BAR; PG8_SCHED;
            PG8_LDB(B1, 1, 1); PG8_STAGE(PG8_SB(1, 0), b3, voffB);
            PG8_BAR; PG8_WAIT_L(0); PG8_MMA(0, 1, At, B1); PG8_BAR;
            PG8_LDA(At, 1, 1); PG8_STAGE(PG8_SA(1, 0), a3, voffA);
            PG8_BAR; PG8_WAIT_L(0); PG8_MMA(1, 0, At, B0); PG8_BAR; PG8_SCHED;
            PG8_STAGE(PG8_SB(1, 1), b3 + hstep, voffB);
            PG8_WAIT_V(6); PG8_BAR; PG8_MMA(1, 1, At, B1); PG8_BAR;
            }
        }
        if constexpr (ALIGN_EPI) { if (wr == 0) PG8_BAR; }
        if constexpr (!Epi::AFTER_DRAIN) { E(acc, cur, wr, wc, fr, fq); S.done(cur); }
        if (!has_next) break;
#pragma unroll
        for (int a = 0; a < 2; ++a)
#pragma unroll
            for (int b = 0; b < 2; ++b)
#pragma unroll
                for (int m = 0; m < 4; ++m)
#pragma unroll
                    for (int n = 0; n < 2; ++n) acc[a][b][m][n] = (f32x4){0.f, 0.f, 0.f, 0.f};
        cur = nxt; cA = nA; cB = nB; ++ui;
        if constexpr (ALIGN_EPI) { if (wr == 1) PG8_BAR; }
    }
    PG8_WAIT_V(0);
    if constexpr (!ALIGN_EPI) { if (wr == 0) PG8_BAR; }
    PG8_BAR;
    if constexpr (Epi::AFTER_DRAIN) { E.fused(acc, cur, wr, wc, fr, fq, lds, wid, lane); S.done(cur); }
#undef PG8_SA
#undef PG8_SB
#undef PG8_STAGE
#undef PG8_LDA
#undef PG8_LDB
#undef PG8_MMA
#undef PG8_WAIT_V
#undef PG8_WAIT_L
#undef PG8_BAR
#undef PG8_SCHED
}
}

constexpr int BATCH = 4, SEQ = 8192, DM = 1024, TOK = BATCH * SEQ;
constexpr int P0W = 2304, P1W = 3072;
constexpr float EPS = 1e-6f, LOG2E = 1.4426950408889634f;
constexpr size_t MiB = 1u << 20;
constexpr size_t WS_WIN0 = 0, WS_WOUT0 = 5 * MiB, WS_WIN1 = 7 * MiB, WS_WOUT1 = 13 * MiB, WS_POOL = 15 * MiB;
constexpr size_t WS_H = 16 * MiB;
constexpr size_t WS_Y = 80 * MiB;
constexpr size_t WS_PROJ = 144 * MiB;
constexpr size_t WS_END = 336 * MiB;
constexpr int LDS_BYTES = 147456;
#ifndef N_LAUNCH_MODE
#define N_LAUNCH_MODE 1
#endif
#ifndef REP0
#define REP0 1
#endif
#ifndef REP1
#define REP1 1
#endif
#ifndef REP2
#define REP2 1
#endif
#ifndef REP3
#define REP3 1
#endif
#ifndef REP4
#define REP4 1
#endif
#ifndef REP5
#define REP5 1
#endif
#ifndef REP6
#define REP6 1
#endif
#ifndef REP7
#define REP7 1
#endif
#ifndef CONV_REP
#define CONV_REP 1
#endif
constexpr int NPHASE = 9;

typedef unsigned short bf16;
typedef short bf16x8 __attribute__((ext_vector_type(8)));
typedef short s16x4 __attribute__((ext_vector_type(4)));
typedef float f32x16 __attribute__((ext_vector_type(16)));
typedef float f32x4 __attribute__((ext_vector_type(4)));
typedef float f32x2 __attribute__((ext_vector_type(2)));
typedef unsigned u32x4 __attribute__((ext_vector_type(4)));
typedef unsigned u32x2 __attribute__((ext_vector_type(2)));
typedef __bf16 bf16x2_t __attribute__((ext_vector_type(2)));

__device__ __forceinline__ float bflo(unsigned u) { return __uint_as_float(u << 16); }
__device__ __forceinline__ float bfhi(unsigned u) { return __uint_as_float(u & 0xffff0000u); }
__device__ __forceinline__ unsigned pk2(float lo, float hi) { f32x2 v = {lo, hi}; bf16x2_t b = __builtin_convertvector(v, bf16x2_t); return __builtin_bit_cast(unsigned, b); }
__device__ __forceinline__ float wave_sum(float v) {
#pragma unroll
    for (int o = 1; o < 64; o <<= 1) v += __shfl_xor(v, o);
    return v;
}
__device__ __forceinline__ float sigm(float x) { return __builtin_amdgcn_rcpf(1.f + __builtin_amdgcn_exp2f(-x * LOG2E)); }
__device__ __forceinline__ float silu(float x) { return x * sigm(x); }
#define LDS_WAIT() asm volatile("s_waitcnt lgkmcnt(0)" ::: "memory")

__device__ __forceinline__ void transpose_item(const float* __restrict__ W, int K, int N, bf16* __restrict__ WT, int row_off, float* scr, int item, int lane) {
    const int nblk = N / 32, kb = item / nblk, nb = item % nblk, k0 = 64 * kb, n0 = 32 * nb;
#pragma unroll 8
    for (int i = 0; i < 32; ++i) { const int kk = 2 * i + (lane >> 5); scr[kk * 33 + (lane & 31)] = W[(size_t)(k0 + kk) * N + n0 + (lane & 31)]; }
    LDS_WAIT();
    const int c = lane & 7;
#pragma unroll
    for (int j = 0; j < 4; ++j) { const int n = (lane >> 3) + 8 * j; const float* s = scr + (8 * c) * 33 + n;
        u32x4 o; o.x = pk2(s[0 * 33], s[1 * 33]); o.y = pk2(s[2 * 33], s[3 * 33]); o.z = pk2(s[4 * 33], s[5 * 33]); o.w = pk2(s[6 * 33], s[7 * 33]);
        *(u32x4*)(WT + (size_t)(row_off + n0 + n) * K + k0 + 8 * c) = o; }
    LDS_WAIT();
}
__device__ __forceinline__ void norm_row_bf16(const float* __restrict__ xrow, const float* __restrict__ g, bf16* __restrict__ orow, int lane) {
    const f32x4* xr = (const f32x4*)xrow + lane; const f32x4* gr = (const f32x4*)g + lane;
    f32x4 v[4]; float s = 0.f;
#pragma unroll
    for (int j = 0; j < 4; ++j) { v[j] = xr[64 * j]; s += (v[j].x * v[j].x + v[j].y * v[j].y) + (v[j].z * v[j].z + v[j].w * v[j].w); }
    const float r = 1.0f / sqrtf(wave_sum(s) * (1.f / DM) + EPS);
    u32x2* o8 = (u32x2*)orow + lane;
#pragma unroll
    for (int j = 0; j < 4; ++j) { const f32x4 gv = gr[64 * j]; u32x2 o; o.x = pk2(v[j].x * r * gv.x, v[j].y * r * gv.y); o.y = pk2(v[j].z * r * gv.z, v[j].w * r * gv.w); o8[64 * j] = o; }
}
__device__ __forceinline__ void resid_row(const float* xrow, const bf16* __restrict__ yrow, const float* __restrict__ gpost, const float* __restrict__ gpre, float* x1row, bf16* __restrict__ hrow, int lane) {
    const u32x2* yr = (const u32x2*)yrow + lane; const f32x4* xr = (const f32x4*)xrow + lane; const f32x4* gp = (const f32x4*)gpost + lane;
    f32x4 y[4]; float s = 0.f;
#pragma unroll
    for (int j = 0; j < 4; ++j) { const u32x2 u = yr[64 * j]; y[j] = (f32x4){bflo(u.x), bfhi(u.x), bflo(u.y), bfhi(u.y)};
        s += (y[j].x * y[j].x + y[j].y * y[j].y) + (y[j].z * y[j].z + y[j].w * y[j].w); }
    const float r = 1.0f / sqrtf(wave_sum(s) * (1.f / DM) + EPS);
    f32x4 x1[4]; float s2 = 0.f;
#pragma unroll
    for (int j = 0; j < 4; ++j) { const f32x4 xv = xr[64 * j]; const f32x4 gv = gp[64 * j]; x1[j] = xv + y[j] * r * gv;
        s2 += (x1[j].x * x1[j].x + x1[j].y * x1[j].y) + (x1[j].z * x1[j].z + x1[j].w * x1[j].w); }
    f32x4* xo = (f32x4*)x1row + lane;
#pragma unroll
    for (int j = 0; j < 4; ++j) xo[64 * j] = x1[j];
    if (hrow) {
        const float r2 = 1.0f / sqrtf(wave_sum(s2) * (1.f / DM) + EPS);
        const f32x4* gq = (const f32x4*)gpre + lane; u32x2* o8 = (u32x2*)hrow + lane;
#pragma unroll
        for (int j = 0; j < 4; ++j) { const f32x4 gv = gq[64 * j]; u32x2 o; o.x = pk2(x1[j].x * r2 * gv.x, x1[j].y * r2 * gv.y); o.y = pk2(x1[j].z * r2 * gv.z, x1[j].w * r2 * gv.w); o8[64 * j] = o; }
    }
}

constexpr int KS_LD = 72, VT_LD = 260, KS_BYTES = 256 * KS_LD * 2;
struct KVRegs { u32x4 k[4], v[4]; };
__device__ __forceinline__ void attn_load(const bf16* __restrict__ proj, int unit, int tid, KVRegs& R) {
    const int kvh = unit & 1, n = (unit >> 1) & 63, b = unit >> 7;
    const long tok0 = (long)b * SEQ + n * 128;
#pragma unroll
    for (int i = 0; i < 4; ++i) {
        const int id = i * 512 + tid, row = id >> 3, c = id & 7;
        const bool ok = (n > 0) || (i >= 2);
        const bf16* src = proj + (ok ? (tok0 - 128 + row) : tok0) * P0W + kvh * 64 + c * 8;
        const u32x4 kv = *(const u32x4*)(src + 512), vv = *(const u32x4*)(src + 640);
        R.k[i] = ok ? kv : (u32x4){0u, 0u, 0u, 0u}; R.v[i] = ok ? vv : (u32x4){0u, 0u, 0u, 0u};
    }
}
__device__ __forceinline__ void attn_store(unsigned char* lds, int tid, const KVRegs& R) {
    bf16* Ks = (bf16*)lds; bf16* Vt = (bf16*)(lds + KS_BYTES);
#pragma unroll
    for (int i = 0; i < 4; ++i) {
        const int id = i * 512 + tid, row = id >> 3, c = id & 7;
        *(u32x4*)(Ks + row * KS_LD + c * 8) = R.k[i];
        const u32x4 vv = R.v[i];
        bf16* vd = Vt + (c * 8) * VT_LD + row;
        vd[0 * VT_LD] = (bf16)(vv.x & 0xffffu); vd[1 * VT_LD] = (bf16)(vv.x >> 16);
        vd[2 * VT_LD] = (bf16)(vv.y & 0xffffu); vd[3 * VT_LD] = (bf16)(vv.y >> 16);
        vd[4 * VT_LD] = (bf16)(vv.z & 0xffffu); vd[5 * VT_LD] = (bf16)(vv.z >> 16);
        vd[6 * VT_LD] = (bf16)(vv.w & 0xffffu); vd[7 * VT_LD] = (bf16)(vv.w >> 16);
    }
}
__device__ __forceinline__ void attn_phase(const bf16* __restrict__ proj, bf16* __restrict__ mix, const float* __restrict__ sinks, unsigned char* lds, int bid, int G, int tid) {
    const int lane = tid & 63, wid = tid >> 6, r32 = lane & 31, hi = lane >> 5;
    const bf16* Ks = (const bf16*)lds; const bf16* Vt = (const bf16*)(lds + KS_BYTES);
    const int g = wid >> 1, qh = wid & 1;
    const float SC2 = 0.125f * LOG2E;
    KVRegs R;
    int unit = bid;
    if (unit < 512) attn_load(proj, unit, tid, R);
#pragma unroll 1
    for (; unit < 512; unit += G) {
        const int kvh = unit & 1, n = (unit >> 1) & 63, b = unit >> 7;
        const long tok0 = (long)b * SEQ + n * 128;
        const int hq = kvh * 4 + g;
        const float slope2 = __builtin_amdgcn_exp2f(-(float)(hq + 1)) * LOG2E;
        const float sink2 = sinks[hq] * LOG2E;
        bf16x8 qf[4];
        { const bf16* qp = proj + (tok0 + qh * 64 + r32) * P0W + hq * 64 + hi * 8;
#pragma unroll
          for (int ds = 0; ds < 4; ++ds) qf[ds] = *(const bf16x8*)(qp + ds * 16); }
        attn_store(lds, tid, R);
        __syncthreads();
        if (unit + G < 512) attn_load(proj, unit + G, tid, R);
#pragma unroll
        for (int sub = 0; sub < 2; ++sub) {
            const int q0 = qh * 64 + sub * 32;
            const long tok = tok0 + q0 + r32;
            u32x2 gu[8];
            { const bf16* gap = proj + tok * P0W + 768 + hq * 64 + 4 * hi;
#pragma unroll
              for (int i = 0; i < 8; ++i) gu[i] = *(const u32x2*)(gap + 8 * i); }
            bf16x8 qn[4];
            if (sub == 0) { const bf16* qp = proj + (tok + 32) * P0W + hq * 64 + hi * 8;
#pragma unroll
                for (int ds = 0; ds < 4; ++ds) qn[ds] = *(const bf16x8*)(qp + ds * 16); }
            f32x16 s[5];
#pragma unroll
            for (int kt = 0; kt < 5; ++kt) {
                f32x16 acc = {0.f, 0.f, 0.f, 0.f, 0.f, 0.f, 0.f, 0.f, 0.f, 0.f, 0.f, 0.f, 0.f, 0.f, 0.f, 0.f};
                const bf16* kp = Ks + (q0 + 32 * kt + r32) * KS_LD + hi * 8;
#pragma unroll
                for (int ds = 0; ds < 4; ++ds) acc = __builtin_amdgcn_mfma_f32_32x32x16_bf16(*(const bf16x8*)(kp + ds * 16), qf[ds], acc, 0, 0, 0);
                s[kt] = acc;
                __builtin_amdgcn_sched_barrier(0);
            }
            float mx = sink2;
            {
                int base_i = 128 + r32 - 4 * hi;
                int lo_i = (n > 0) ? (base_i - 128) : max(base_i - 128, 127 - q0 - 4 * hi);
                float sbf = slope2 * (float)base_i;
                asm volatile("" : "+v"(base_i), "+v"(lo_i), "+v"(sbf));
#pragma unroll
                for (int kt = 0; kt < 5; ++kt)
#pragma unroll
                    for (int r = 0; r < 16; ++r) {
                        const int cc = 32 * kt + (r & 3) + 8 * (r >> 2);
                        const bool valid = (cc <= base_i) && (cc > lo_i);
                        const float bias = fmaf(slope2, (float)cc, -sbf);
                        const float v = valid ? fmaf(s[kt][r], SC2, bias) : -INFINITY;
                        s[kt][r] = v; mx = fmaxf(mx, v);
                    }
            }
            mx = fmaxf(mx, __shfl_xor(mx, 32));
            float sum = 0.f;
#pragma unroll
            for (int kt = 0; kt < 5; ++kt)
#pragma unroll
                for (int r = 0; r < 16; ++r) { const float p = __builtin_amdgcn_exp2f(s[kt][r] - mx); s[kt][r] = p; sum += p; }
            sum += __shfl_xor(sum, 32);
            const float inv = 1.0f / (sum + __builtin_amdgcn_exp2f(sink2 - mx));
            f32x16 ot[2];
#pragma unroll
            for (int dt = 0; dt < 2; ++dt) ot[dt] = (f32x16){0.f, 0.f, 0.f, 0.f, 0.f, 0.f, 0.f, 0.f, 0.f, 0.f, 0.f, 0.f, 0.f, 0.f, 0.f, 0.f};
#pragma unroll
            for (int kt = 0; kt < 5; ++kt)
#pragma unroll
                for (int si = 0; si < 2; ++si) {
                    u32x4 pw; pw.x = pk2(s[kt][8 * si + 0], s[kt][8 * si + 1]); pw.y = pk2(s[kt][8 * si + 2], s[kt][8 * si + 3]);
                    pw.z = pk2(s[kt][8 * si + 4], s[kt][8 * si + 5]); pw.w = pk2(s[kt][8 * si + 6], s[kt][8 * si + 7]);
                    const bf16x8 pf = __builtin_bit_cast(bf16x8, pw);
                    const int kb = q0 + 32 * kt + 16 * si + 4 * hi;
#pragma unroll
                    for (int dt = 0; dt < 2; ++dt) {
                        const bf16* vp = Vt + (dt * 32 + r32) * VT_LD + kb;
                        const s16x4 lo4 = *(const s16x4*)vp, hi4 = *(const s16x4*)(vp + 8);
                        const bf16x8 vf = {lo4[0], lo4[1], lo4[2], lo4[3], hi4[0], hi4[1], hi4[2], hi4[3]};
                        ot[dt] = __builtin_amdgcn_mfma_f32_32x32x16_bf16(vf, pf, ot[dt], 0, 0, 0);
                    }
                    __builtin_amdgcn_sched_barrier(0);
                }
            bf16* op = mix + tok * DM + hq * 64 + 4 * hi;
#pragma unroll
            for (int dt = 0; dt < 2; ++dt)
#pragma unroll
                for (int rg = 0; rg < 4; ++rg) {
                    const u32x2 gv = gu[4 * dt + rg];
                    u32x2 o;
                    o.x = pk2(ot[dt][4 * rg + 0] * inv * silu(bflo(gv.x)), ot[dt][4 * rg + 1] * inv * silu(bfhi(gv.x)));
                    o.y = pk2(ot[dt][4 * rg + 2] * inv * silu(bflo(gv.y)), ot[dt][4 * rg + 3] * inv * silu(bfhi(gv.y)));
                    *(u32x2*)(op + 32 * dt + 8 * rg) = o;
                }
            if (sub == 0) {
#pragma unroll
                for (int ds = 0; ds < 4; ++ds) qf[ds] = qn[ds];
            }
        }
        __syncthreads();
    }
}

constexpr int U_LD = 128, PL_LD = 136, U_BYTES = 144 * U_LD * 2;
struct URegs { u32x4 v[5]; };
__device__ __forceinline__ void pool_load(const bf16* __restrict__ proj, int unit, int tid, URegs& R) {
    const int g = unit & 3, n = (unit >> 2) & 63, b = unit >> 8;
    const long tok0 = (long)b * SEQ + n * 128;
#pragma unroll
    for (int i = 0; i < 5; ++i) {
        const int id = i * 512 + tid, row = id >> 4, c = id & 15;
        if (i < 4 || tid < 256) {
            const bool ok = (n > 0) || (row >= 16);
            const u32x4 v = *(const u32x4*)(proj + (ok ? (tok0 - 16 + row) : tok0) * P0W + 1280 + g * 128 + c * 8);
            R.v[i] = ok ? v : (u32x4){0u, 0u, 0u, 0u};
        }
    }
}
__device__ __forceinline__ void pool_phase(const bf16* __restrict__ proj, bf16* __restrict__ mix, const bf16* __restrict__ poolT, const float* __restrict__ pscale, unsigned char* lds, int bid, int G, int tid) {
    const int lane = tid & 63, wid = tid >> 6, r32 = lane & 31, hi = lane >> 5;
    bf16* U = (bf16*)lds;
    bf16* Pl = (bf16*)(lds + U_BYTES);
    URegs R;
    int unit = bid;
    if (unit < 1024) pool_load(proj, unit, tid, R);
#pragma unroll 1
    for (; unit < 1024; unit += G) {
        const int g = unit & 3, n = (unit >> 2) & 63, b = unit >> 8;
        const long tok0 = (long)b * SEQ + n * 128;
#pragma unroll
        for (int i = 0; i < 5; ++i) { const int id = i * 512 + tid, row = id >> 4, c = id & 15; if (i < 4 || tid < 256) *(u32x4*)(U + row * U_LD + c * 8) = R.v[i]; }
        __syncthreads();
        if (unit + G < 1024) pool_load(proj, unit + G, tid, R);
        const int tt = wid >> 1, dbase = (wid & 1) * 64;
        const long tok = tok0 + tt * 32 + r32;
        u32x2 gu[8]; f32x4 sc[8];
        { const bf16* gbp = proj + tok * P0W + 1792 + g * 128 + dbase + 4 * hi; const float* scp = pscale + g * 128 + dbase + 4 * hi;
#pragma unroll
          for (int i = 0; i < 8; ++i) { gu[i] = *(const u32x2*)(gbp + 8 * i); sc[i] = *(const f32x4*)(scp + 8 * i); } }
        {
            const int cp = tid & 63, tg = tid >> 6, w = 2 << g;
#pragma unroll 1
            for (int t2 = 0; t2 < 16; ++t2) {
                const int t = tg * 16 + t2;
                float s0 = 0.f, s1 = 0.f;
                for (int i = 0; i < w; ++i) { const unsigned u = *(const unsigned*)(U + (16 + t - i) * U_LD + 2 * cp); s0 += bflo(u); s1 += bfhi(u); }
                const unsigned uc = *(const unsigned*)(U + (16 + t) * U_LD + 2 * cp);
                const int pos = n * 128 + t; const int cnt = (pos + 1 < w) ? (pos + 1) : w; const float ic = 1.0f / (float)cnt;
                *(unsigned*)(Pl + t * PL_LD + 2 * cp) = pk2(s0 * ic - bflo(uc), s1 * ic - bfhi(uc));
            }
        }
        __syncthreads();
#pragma unroll
        for (int dti = 0; dti < 2; ++dti) {
            const int dt0 = dbase + dti * 32;
            f32x16 acc = {0.f, 0.f, 0.f, 0.f, 0.f, 0.f, 0.f, 0.f, 0.f, 0.f, 0.f, 0.f, 0.f, 0.f, 0.f, 0.f};
            const bf16* ap = poolT + (size_t)(g * 128 + dt0 + r32) * 128 + hi * 8;
            const bf16* bp = Pl + (tt * 32 + r32) * PL_LD + hi * 8;
#pragma unroll
            for (int ks = 0; ks < 8; ++ks) acc = __builtin_amdgcn_mfma_f32_32x32x16_bf16(*(const bf16x8*)(ap + ks * 16), *(const bf16x8*)(bp + ks * 16), acc, 0, 0, 0);
            bf16* op = mix + tok * DM + 512 + g * 128 + dt0 + 4 * hi;
#pragma unroll
            for (int rg = 0; rg < 4; ++rg) {
                const u32x2 gv = gu[4 * dti + rg]; const f32x4 sv = sc[4 * dti + rg];
                u32x2 o;
                o.x = pk2(acc[4 * rg + 0] * sv.x * silu(bflo(gv.x)), acc[4 * rg + 1] * sv.y * silu(bfhi(gv.x)));
                o.y = pk2(acc[4 * rg + 2] * sv.z * silu(bflo(gv.y)), acc[4 * rg + 3] * sv.w * silu(bfhi(gv.y)));
                *(u32x2*)(op + 8 * rg) = o;
            }
        }
    }
    __syncthreads();
}

namespace pg8 {
struct EpiGlu {
    static constexpr bool PERM = true, AFTER_DRAIN = false;
    bf16_t* O;
    __device__ __forceinline__ void operator()(const f32x4 (&acc)[2][2][4][2], const Unit& u, int wr, int wc, int fr, int fq) const {
        const int row0 = u.pm * BM + wr * 64 + fr;
        if (u.pn < 8) {
            const int col0 = u.pn * 128 + wc * 32 + 8 * fq;
#pragma unroll
            for (int ai = 0; ai < 2; ++ai)
#pragma unroll
                for (int m = 0; m < 4; ++m) {
                    bf16_t* rowp = O + (size_t)(row0 + ai * HALF + m * 16) * 2048 + col0;
                    const f32x4 a0 = acc[ai][0][m][0], a1 = acc[ai][0][m][1], b0 = acc[ai][1][m][0], b1 = acc[ai][1][m][1];
                    u32x4 w;
                    w.x = ::pk2(a0[0] * ::sigm(b0[0]), a0[1] * ::sigm(b0[1])); w.y = ::pk2(a0[2] * ::sigm(b0[2]), a0[3] * ::sigm(b0[3]));
                    w.z = ::pk2(a1[0] * ::sigm(b1[0]), a1[1] * ::sigm(b1[1])); w.w = ::pk2(a1[2] * ::sigm(b1[2]), a1[3] * ::sigm(b1[3]));
                    *(u32x4*)rowp = w;
                }
        } else {
            const int col0 = 1024 + (u.pn - 8) * 256 + wc * 32 + 8 * fq;
#pragma unroll
            for (int ai = 0; ai < 2; ++ai)
#pragma unroll
                for (int m = 0; m < 4; ++m) {
                    bf16_t* rowp = O + (size_t)(row0 + ai * HALF + m * 16) * 2048 + col0;
#pragma unroll
                    for (int bj = 0; bj < 2; ++bj) {
                        const f32x4 v0 = acc[ai][bj][m][0], v1 = acc[ai][bj][m][1];
                        u32x4 w;
                        w.x = ::pk2(::silu(v0[0]), ::silu(v0[1])); w.y = ::pk2(::silu(v0[2]), ::silu(v0[3]));
                        w.z = ::pk2(::silu(v1[0]), ::silu(v1[1])); w.w = ::pk2(::silu(v1[2]), ::silu(v1[3]));
                        *(u32x4*)(rowp + bj * HALF) = w;
                    }
                }
        }
    }
};
}

constexpr int GLW = 2048;
template <bool CHECK> __device__ __forceinline__ void conv_accum(f32x2 (&acc)[16], const f32x2 (&w)[31], const unsigned* gbase, int p0) {
#pragma unroll
    for (int j = 0; j < 46; ++j) {
        f32x2 x = {0.f, 0.f};
        if (!CHECK || p0 + j >= 30) { const unsigned u = gbase[(j - 30) * (GLW / 2)]; x = (f32x2){bflo(u), bfhi(u)}; }
#pragma unroll
        for (int t = 0; t < 16; ++t) { const int k = j - t; if (k >= 0 && k <= 30) acc[t] = __builtin_elementwise_fma(x, w[k], acc[t]); }
    }
}
__device__ __forceinline__ void conv_phase(const bf16* __restrict__ gl, bf16* __restrict__ z, const float* __restrict__ dww, const float* __restrict__ dwb,
                                          const float* __restrict__ lng, const float* __restrict__ lnb, unsigned char* lds, int bid, int G, int tid) {
    const int lane = tid & 63, wid = tid >> 6;
    float* red = (float*)lds;
    float* stat = (float*)(lds + 1024);
    f32x2 w[31];
#pragma unroll
    for (int k = 0; k < 31; ++k) { const f32x2* wp = (const f32x2*)(dww + k * 1024); w[k] = wp[tid]; }
    const f32x2 bias = ((const f32x2*)dwb)[tid], gg = ((const f32x2*)lng)[tid], bb2 = ((const f32x2*)lnb)[tid];
#pragma unroll 1
    for (int unit_ = bid; unit_ < CONV_REP * (TOK / 16); unit_ += G) {
    const int unit = unit_ % (TOK / 16);
    const long tok0 = (long)unit * 16; const int p0 = (int)(tok0 & (SEQ - 1));
    const unsigned* gbase = (const unsigned*)(gl + tok0 * GLW) + tid;
    unsigned* zbase = (unsigned*)(z + tok0 * DM) + tid;
    asm volatile("" : "+v"(gbase), "+v"(zbase));
    f32x2 acc[16];
#pragma unroll
    for (int t = 0; t < 16; ++t) acc[t] = bias;
    if (p0 >= 32) conv_accum<false>(acc, w, gbase, p0); else conv_accum<true>(acc, w, gbase, p0);
    unsigned ug[16];
#pragma unroll
    for (int t = 0; t < 16; ++t) ug[t] = gbase[t * (GLW / 2) + 512];
    {
        float v[32];
#pragma unroll
        for (int t = 0; t < 16; ++t) { const float a0 = acc[t].x, a1 = acc[t].y; v[2 * t] = a0 + a1; v[2 * t + 1] = a0 * a0 + a1 * a1; }
#pragma unroll
        for (int step = 0; step < 5; ++step) {
            const int half = 16 >> step; const bool up = (lane >> step) & 1;
#pragma unroll
            for (int i = 0; i < half; ++i) { const float va = v[i], vb = v[i + half]; const float send = up ? va : vb; const float keep = up ? vb : va; v[i] = keep + __shfl_xor(send, 1 << step); }
        }
        v[0] += __shfl_xor(v[0], 32);
        const int idx = ((lane & 1) << 4) | ((lane & 2) << 2) | (lane & 4) | ((lane & 8) >> 2) | ((lane & 16) >> 4);
        if (lane < 32) red[wid * 32 + idx] = v[0];
    }
    __syncthreads();
    if (tid < 16) {
        float s1 = 0.f, s2 = 0.f;
#pragma unroll
        for (int ww = 0; ww < 8; ++ww) { s1 += red[ww * 32 + 2 * tid]; s2 += red[ww * 32 + 2 * tid + 1]; }
        const float mu = s1 * (1.f / 1024.f); float var = s2 * (1.f / 1024.f) - mu * mu; var = var > 0.f ? var : 0.f;
        stat[2 * tid] = mu; stat[2 * tid + 1] = 1.0f / sqrtf(var + EPS);
    }
    __syncthreads();
#pragma unroll
    for (int t = 0; t < 16; ++t) {
        const float mu = stat[2 * t], rs = stat[2 * t + 1];
        const float cn0 = (acc[t].x - mu) * rs * gg.x + bb2.x, cn1 = (acc[t].y - mu) * rs * gg.y + bb2.y;
        zbase[t * (DM / 2)] = pk2(silu(cn0) * bflo(ug[t]), silu(cn1) * bfhi(ug[t]));
    }
    }
    __syncthreads();
}

struct Args { const float* in[14]; float* out; unsigned char* ws; int ph_lo, ph_hi; };
__global__ void __launch_bounds__(512, 2) fwd_kernel(Args a) {
    extern __shared__ __attribute__((aligned(16))) unsigned char lds[];
    cg::grid_group grid = cg::this_grid();
    const int tid = threadIdx.x, lane = tid & 63, wid = __builtin_amdgcn_readfirstlane(tid >> 6);
    const int G = gridDim.x, bid = blockIdx.x;
    const int gw = bid * 8 + wid, NGW = G * 8;
    const int lo = a.ph_lo, hi = a.ph_hi;
    unsigned char* ws = a.ws;
    const float* x = a.in[0]; const float* pre_norm = a.in[1]; const float* post_norm = a.in[2];
    bf16* Win0 = (bf16*)(ws + WS_WIN0); bf16* Wout0 = (bf16*)(ws + WS_WOUT0); bf16* Win1 = (bf16*)(ws + WS_WIN1); bf16* Wout1 = (bf16*)(ws + WS_WOUT1); bf16* PoolT = (bf16*)(ws + WS_POOL);
    bf16* Hb = (bf16*)(ws + WS_H); bf16* Yb = (bf16*)(ws + WS_Y); bf16* Pb = (bf16*)(ws + WS_PROJ);
    PG8_LAS unsigned char* lds3 = (PG8_LAS unsigned char*)lds;
#define IN(k) (lo <= (k) && (k) < hi)
#define SEAM(k) do { if (IN(k) && IN((k) + 1)) grid.sync(); } while (0)

    if (IN(0)) _Pragma("unroll") for (int rp_ = 0; rp_ < REP0; ++rp_) {
        float* scr = (float*)(lds + wid * 16384);
        constexpr int I_IN0 = 16 * 72, I_OUT = 16 * 32, I_IN1 = 16 * 96, I_POOL = 32;
        constexpr int NITEMS = I_IN0 + I_OUT + I_IN1 + I_OUT + I_POOL;
        for (int it = gw; it < NITEMS; it += NGW) {
            int r = it;
            if (r < I_IN0) { transpose_item(a.in[3], 1024, P0W, Win0, 0, scr, r, lane); continue; } r -= I_IN0;
            if (r < I_OUT) { transpose_item(a.in[7], 1024, 1024, Wout0, 0, scr, r, lane); continue; } r -= I_OUT;
            if (r < I_IN1) { const int n0 = 32 * (r % 96);
                const int d0 = (n0 < 2048) ? (((n0 & 1023) >> 7) * 256 + (n0 >> 10) * 128 + (n0 & 127)) : n0;
                transpose_item(a.in[8], 1024, P1W, Win1, d0 - n0, scr, r, lane); continue; } r -= I_IN1;
            if (r < I_OUT) { transpose_item(a.in[13], 1024, 1024, Wout1, 0, scr, r, lane); continue; } r -= I_OUT;
            { const int gi = r >> 3; transpose_item(a.in[5] + gi * 16384, 128, 128, PoolT + gi * 16384, 0, scr, r & 7, lane); }
        }
        for (int m = gw; m < TOK; m += NGW) norm_row_bf16(x + (size_t)m * DM, pre_norm, Hb + (size_t)m * DM, lane);
    }
    SEAM(0);
    if (IN(1)) _Pragma("unroll") for (int rp_ = 0; rp_ < REP1; ++rp_) {
        pg8::Gemm g{Hb, Win0, TOK, P0W, DM}; pg8::StaticOrder S; S.init(TOK, P0W, G, bid);
        pg8::EpiBf16<0> E{Pb, P0W, nullptr, 0, 0, 1.f};
        pg8::gemm_phase<pg8::EpiBf16<0>, pg8::StaticOrder, true, true>(lds3, g, S, E);
    }
    SEAM(1);
    if (IN(2)) _Pragma("unroll") for (int rp_ = 0; rp_ < REP2; ++rp_) {
        __syncthreads();
        attn_phase(Pb, Hb, a.in[4], lds, bid, G, tid);
        pool_phase(Pb, Hb, PoolT, a.in[6], lds, bid, G, tid);
    }
    SEAM(2);
    if (IN(3)) _Pragma("unroll") for (int rp_ = 0; rp_ < REP3; ++rp_) {
        pg8::Gemm g{Hb, Wout0, TOK, DM, DM}; pg8::StaticOrder S; S.init(TOK, DM, G, bid);
        pg8::EpiBf16<0> E{Yb, DM, nullptr, 0, 0, 1.f};
        pg8::gemm_phase<pg8::EpiBf16<0>, pg8::StaticOrder, true, true>(lds3, g, S, E);
    }
    SEAM(3);
    if (IN(4)) _Pragma("unroll") for (int rp_ = 0; rp_ < REP4; ++rp_) {
        for (int m = gw; m < TOK; m += NGW) resid_row(x + (size_t)m * DM, Yb + (size_t)m * DM, post_norm, pre_norm + DM, a.out + (size_t)m * DM, Hb + (size_t)m * DM, lane);
    }
    SEAM(4);
    if (IN(5)) _Pragma("unroll") for (int rp_ = 0; rp_ < REP5; ++rp_) {
        pg8::Gemm g{Hb, Win1, TOK, P1W, DM}; pg8::StaticOrder S; S.init(TOK, P1W, G, bid);
        pg8::EpiGlu E{Pb};
        pg8::gemm_phase<pg8::EpiGlu, pg8::StaticOrder, true, true>(lds3, g, S, E);
    }
    SEAM(5);
    if (IN(6)) _Pragma("unroll") for (int rp_ = 0; rp_ < REP6; ++rp_) {
        __syncthreads();
        conv_phase(Pb, Hb, a.in[9], a.in[10], a.in[11], a.in[12], lds, bid, G, tid);
    }
    SEAM(6);
    if (IN(7)) _Pragma("unroll") for (int rp_ = 0; rp_ < REP7; ++rp_) {
        pg8::Gemm g{Hb, Wout1, TOK, DM, DM}; pg8::StaticOrder S; S.init(TOK, DM, G, bid);
        pg8::EpiBf16<0> E{Yb, DM, nullptr, 0, 0, 1.f};
        pg8::gemm_phase<pg8::EpiBf16<0>, pg8::StaticOrder, true, true>(lds3, g, S, E);
    }
    SEAM(7);
    if (IN(8)) {
        for (int m = gw; m < TOK; m += NGW) resid_row(a.out + (size_t)m * DM, Yb + (size_t)m * DM, post_norm + DM, nullptr, a.out + (size_t)m * DM, nullptr, lane);
    }
#undef IN
#undef SEAM
}

extern "C" void kernel_launch(void* const* d_in, const int* in_sizes, int n_in, void* d_out, int out_size, void* d_ws, size_t ws_size, hipStream_t stream) {
    static int grid = 0;
    if (grid == 0) {
        if (n_in != 14 || out_size != TOK * DM || ws_size < WS_END) { fprintf(stderr, "kernel_launch: unexpected shapes (n_in %d, out %d, ws %zu)\n", n_in, out_size, ws_size); grid = -1; return; }
        int dev = 0, cus = 0, per_cu = 0;
        hipGetDevice(&dev);
        hipDeviceGetAttribute(&cus, hipDeviceAttributeMultiprocessorCount, dev);
        if (hipFuncSetAttribute((const void*)fwd_kernel, hipFuncAttributeMaxDynamicSharedMemorySize, LDS_BYTES) != hipSuccess) { fprintf(stderr, "kernel_launch: hipFuncSetAttribute failed\n"); grid = -1; return; }
        if (hipOccupancyMaxActiveBlocksPerMultiprocessor(&per_cu, (const void*)fwd_kernel, 512, LDS_BYTES) != hipSuccess || per_cu < 1) { fprintf(stderr, "kernel_launch: occupancy query says %d\n", per_cu); per_cu = 1; }
        (void)hipGetLastError();
        grid = cus * 1;
        if (grid <= 0) grid = 256;
    }
    if (grid < 0) return;
    Args a{};
    for (int i = 0; i < 14; ++i) a.in[i] = (const float*)d_in[i];
    a.out = (float*)d_out; a.ws = (unsigned char*)d_ws;
#if N_LAUNCH_MODE == 1
    a.ph_lo = 0; a.ph_hi = NPHASE;
    void* args[] = {&a};
    hipError_t e = hipLaunchCooperativeKernel((const void*)fwd_kernel, dim3(grid), dim3(512), args, LDS_BYTES, stream);
    if (e != hipSuccess) fprintf(stderr, "cooperative launch failed: %s (grid %d)\n", hipGetErrorString(e), grid);
#else
    for (int p = 0; p < NPHASE; ++p) {
        a.ph_lo = p; a.ph_hi = p + 1;
        hipLaunchKernelGGL(fwd_kernel, dim3(grid), dim3(512), LDS_BYTES, stream, a);
    }
#endif
}
```

```cpp
#include <hip/hip_runtime.h>
#include <hip/hip_cooperative_groups.h>
#include <cstdio>
#include <cstdint>
namespace cg = cooperative_groups;
#define N_LAUNCH_MODE 1
namespace pg8 {
#define PG8_LAS __attribute__((address_space(3)))
typedef unsigned short bf16_t;
typedef short bf16x8 __attribute__((ext_vector_type(8)));
typedef float f32x4 __attribute__((ext_vector_type(4)));
typedef unsigned u32x4 __attribute__((ext_vector_type(4)));
constexpr int BM = 256, BK = 64, HALF = 128, HTB = HALF * BK * 2  , STAGE_BYTES = 8 * HTB, NXCD = 8, WGM = 8;

__host__ __device__ __forceinline__ int lds_byte(int r, int c) { const int st = (r >> 4) * 2 + (c >> 5), rr = r & 15, cc = c & 31, ob = rr * 64 + cc * 2; return st * 1024 + (ob ^ (((ob >> 9) & 1) << 5)); }
__host__ __device__ __forceinline__ void stage_rc(int b, int& R, int& C) { const int st = b / 1024, sb = b % 1024, swz = sb ^ (((sb >> 9) & 1) << 5); R = (st >> 1) * 16 + swz / 64; C = (st & 1) * 32 + (swz % 64) / 2; }
__host__ __device__ __forceinline__ int perm32(int rho) { const int n = rho >> 4, i = rho & 15; return 8 * (i >> 2) + 4 * n + (i & 3); }

struct Unit { int pm, pn; };
struct Gemm { const bf16_t* A; const bf16_t* Bt; int M, N, K; };

struct StaticOrder {
    int nM, nN, nwg, G, c;
    __host__ __device__ void init(int M, int N, int G_, int c_) { nM = M / BM; nN = N / BM; nwg = nM * nN; G = G_; c = c_; }
    __host__ __device__ bool next(int i, Unit& u) const {
        const long L = (long)i * G + c; if (L >= nwg) return false;
        int wgid = (int)L; { const int q = nwg / NXCD, r = nwg % NXCD, xcd = wgid % NXCD, off = wgid / NXCD; wgid = (xcd < r ? xcd * (q + 1) : r * (q + 1) + (xcd - r) * q) + off; }
        const int nig = WGM * nN, gid = wgid / nig, fm = gid * WGM, gsz = (nM - fm) < WGM ? (nM - fm) : WGM;
        u.pm = fm + ((wgid % nig) % gsz); u.pn = (wgid % nig) / gsz; return true;
    }
    __device__ __forceinline__ void a_ready(const Unit&) const {}
    __device__ __forceinline__ void done(const Unit&) const {}
};

__device__ __forceinline__ unsigned cvt_pk_bf16(float lo, float hi) { unsigned r; asm volatile("v_cvt_pk_bf16_f32 %0, %1, %2" : "=v"(r) : "v"(lo), "v"(hi)); return r; }
typedef float f32x2 __attribute__((ext_vector_type(2)));
__device__ __forceinline__ f32x2 gelu_pk(f32x2 v) {
    const f32x2 av = __builtin_elementwise_abs(v), d = av * 0.2316418882f + 1.0f;
    f32x2 t; t.x = __builtin_amdgcn_rcpf(d.x); t.y = __builtin_amdgcn_rcpf(d.y);
    f32x2 q = t * 0.5307027145f + (-0.7265760135f); q = q * t + 0.7107068705f; q = q * t + (-0.142248368f); q = q * t + 0.127414796f; q = q * t;
    const f32x2 s = (v * v) * (-0.72134752044f);
    f32x2 e; e.x = __builtin_amdgcn_exp2f(s.x); e.y = __builtin_amdgcn_exp2f(s.y);
    const f32x2 m = v * (q * e), r = v - m;
    f32x2 o; o.x = v.x < 0.f ? m.x : r.x; o.y = v.y < 0.f ? m.y : r.y; return o;
}

template <int ACT  > struct EpiBf16 {
    static constexpr bool PERM = true, AFTER_DRAIN = false; static_assert(ACT == 0 || ACT == 1, "EpiBf16: ACT is 0 (none) or 1 (gelu_pk)");
    bf16_t* O; int ldc; const float* bias; int split_cols; size_t split_stride; float scale0;
    __device__ __forceinline__ void operator()(const f32x4 (&acc)[2][2][4][2], const Unit& u, int wr, int wc, int fr, int fq) const {
        const int row0 = u.pm * BM + wr * 64 + fr; int colt = u.pn * BM; bf16_t* base = O;
        float sc = 1.f; if (split_cols) { const int t = colt / split_cols; base += (size_t)t * split_stride; colt -= t * split_cols; if (t == 0) sc = scale0; }
        const int col0 = colt + wc * 32 + 8 * fq, bcol0 = u.pn * BM + wc * 32 + 8 * fq;
        f32x4 bv[2][2];
#pragma unroll
        for (int bj = 0; bj < 2; ++bj)
#pragma unroll
            for (int n = 0; n < 2; ++n) bv[bj][n] = bias ? *(const f32x4*)(bias + bcol0 + bj * HALF + 4 * n) : (f32x4){0.f, 0.f, 0.f, 0.f};
#pragma unroll
        for (int ai = 0; ai < 2; ++ai)
#pragma unroll
            for (int m = 0; m < 4; ++m) { bf16_t* rowp = base + (size_t)(row0 + ai * HALF + m * 16) * ldc + col0;
#pragma unroll
                for (int bj = 0; bj < 2; ++bj) { f32x4 v0 = acc[ai][bj][m][0] + bv[bj][0], v1 = acc[ai][bj][m][1] + bv[bj][1];
                    if (ACT == 1) { f32x2 a = gelu_pk((f32x2){v0[0], v0[1]}), b = gelu_pk((f32x2){v0[2], v0[3]}), c = gelu_pk((f32x2){v1[0], v1[1]}), d = gelu_pk((f32x2){v1[2], v1[3]});
                        v0 = (f32x4){a.x, a.y, b.x, b.y}; v1 = (f32x4){c.x, c.y, d.x, d.y}; }
                    v0 = v0 * sc; v1 = v1 * sc; u32x4 w; w.x = cvt_pk_bf16(v0[0], v0[1]); w.y = cvt_pk_bf16(v0[2], v0[3]); w.z = cvt_pk_bf16(v1[0], v1[1]); w.w = cvt_pk_bf16(v1[2], v1[3]);
                    *(u32x4*)(rowp + bj * HALF) = w; } }
    }
};
template <class Epi, class Sched, bool ALIGN_EPI = false, bool SP2 = false>
__device__ __forceinline__ void gemm_phase(PG8_LAS unsigned char* lds, const Gemm g, const Sched& S, const Epi& E) {
    const int tid = threadIdx.x, wid = __builtin_amdgcn_readfirstlane(tid >> 6), lane = tid & 63, wr = wid >> 2, wc = wid & 3, fr = lane & 15, fq = lane >> 4;
    const int K = g.K, nt = K / BK;
    unsigned voffA[2], voffB[2];
#pragma unroll
    for (int i = 0; i < 2; ++i) { int R, C; stage_rc(tid * 16 + i * 8192, R, C); const int Rb = Epi::PERM ? ((R & ~31) + perm32(R & 31)) : R;
        voffA[i] = (unsigned)(R * K + C) * 2u; voffB[i] = (unsigned)(Rb * K + C) * 2u; }
    const size_t kstep = (size_t)(BK * 2);
    const size_t hstep = (size_t)HALF * K * 2;
    const size_t tstep = 2 * hstep;
    const unsigned ldsw = (unsigned)wid * 1024u;
    const int aoff = lds_byte(wr * 64 + fr, fq * 8), boff = lds_byte(wc * 32 + fr, fq * 8);
#define PG8_SA(b, h) (((b) * 2 + (h)) * HTB)
#define PG8_SB(b, h) ((4 + (b) * 2 + (h)) * HTB)
#define PG8_STAGE(bufoff, gbase, voff) do { _Pragma("unroll") for (int _i = 0; _i < 2; ++_i) \
        __builtin_amdgcn_global_load_lds((const unsigned*)((const char*)(gbase) + (voff)[_i]), (PG8_LAS unsigned*)(lds + (bufoff) + ldsw + _i * 8192), 16, 0, 0); } while (0)
#define PG8_LDA(dst, b, h) do { _Pragma("unroll") for (int m = 0; m < 4; ++m) _Pragma("unroll") for (int k = 0; k < 2; ++k) dst[m][k] = *(const PG8_LAS bf16x8*)(lds + PG8_SA(b, h) + aoff + m * 2048 + k * 1024); } while (0)
#define PG8_LDB(dst, b, h) do { _Pragma("unroll") for (int n = 0; n < 2; ++n) _Pragma("unroll") for (int k = 0; k < 2; ++k) dst[n][k] = *(const PG8_LAS bf16x8*)(lds + PG8_SB(b, h) + boff + n * 2048 + k * 1024); } while (0)
#define PG8_MMA(ai, bj, At, Bt) do { __builtin_amdgcn_s_setprio(1); _Pragma("unroll") for (int m = 0; m < 4; ++m) _Pragma("unroll") for (int n = 0; n < 2; ++n) _Pragma("unroll") for (int k = 0; k < 2; ++k) \
        acc[ai][bj][m][n] = __builtin_amdgcn_mfma_f32_16x16x32_bf16(Bt[n][k], At[m][k], acc[ai][bj][m][n], 0, 0, 0); __builtin_amdgcn_s_setprio(0); } while (0)
#define PG8_WAIT_V(n) asm volatile("s_waitcnt vmcnt(" #n ")" ::: "memory")
#define PG8_WAIT_L(n) asm volatile("s_waitcnt lgkmcnt(" #n ")" ::: "memory")
#define PG8_BAR __builtin_amdgcn_s_barrier()
#define PG8_SCHED __builtin_amdgcn_sched_barrier(0)
    Unit cur, nxt; int ui = 0;
    if (!S.next(0, cur)) return;
    f32x4 acc[2][2][4][2];
#pragma unroll
    for (int a = 0; a < 2; ++a)
#pragma unroll
        for (int b = 0; b < 2; ++b)
#pragma unroll
            for (int m = 0; m < 4; ++m)
#pragma unroll
                for (int n = 0; n < 2; ++n) acc[a][b][m][n] = (f32x4){0.f, 0.f, 0.f, 0.f};
    bf16x8 At[4][2], B0[2][2], B1[2][2];
    const char* cA = (const char*)g.A + (size_t)cur.pm * tstep; const char* cB = (const char*)g.Bt + (size_t)cur.pn * tstep;
    S.a_ready(cur);
    if constexpr (SP2) {
        PG8_STAGE(PG8_SB(0, 0), cB, voffB); PG8_STAGE(PG8_SB(0, 1), cB + hstep, voffB); PG8_STAGE(PG8_SA(0, 0), cA, voffA); PG8_STAGE(PG8_SA(0, 1), cA + hstep, voffA);
        if (wr == 1) PG8_BAR;
        PG8_WAIT_V(2); PG8_BAR;
        PG8_STAGE(PG8_SB(1, 0), cB + kstep, voffB); PG8_STAGE(PG8_SA(1, 0), cA + kstep, voffA); PG8_STAGE(PG8_SB(1, 1), cB + hstep + kstep, voffB);
        PG8_WAIT_V(6); PG8_BAR;
    } else {
        PG8_STAGE(PG8_SB(0, 0), cB, voffB); PG8_STAGE(PG8_SA(0, 0), cA, voffA); PG8_STAGE(PG8_SB(0, 1), cB + hstep, voffB); PG8_STAGE(PG8_SA(0, 1), cA + hstep, voffA);
        if (wr == 1) PG8_BAR;
        PG8_WAIT_V(4); PG8_BAR;
        PG8_STAGE(PG8_SB(1, 0), cB + kstep, voffB); PG8_STAGE(PG8_SA(1, 0), cA + kstep, voffA); PG8_STAGE(PG8_SB(1, 1), cB + hstep + kstep, voffB);
        PG8_WAIT_V(6); PG8_BAR;
    }
    for (;;) {
        const bool has_next = S.next(ui + 1, nxt);
        const char* nA = has_next ? (const char*)g.A + (size_t)nxt.pm * tstep : cA; const char* nB = has_next ? (const char*)g.Bt + (size_t)nxt.pn * tstep : cB;
        for (int t = 0; t < nt; t += 2) {
            const bool last = (t == nt - 2);
            const char* a1 = cA + (size_t)(t + 1) * kstep;
            const char* a2 = last ? nA : cA + (size_t)(t + 2) * kstep; const char* b2 = last ? nB : cB + (size_t)(t + 2) * kstep;
            const char* a3 = a2 + kstep; const char* b3 = b2 + kstep;
            if (last && has_next) S.a_ready(nxt);
            if constexpr (SP2) {
            PG8_LDB(B0, 0, 0); PG8_LDB(B1, 0, 1); PG8_SCHED; PG8_LDA(At, 0, 0); PG8_STAGE(PG8_SA(1, 1), a1 + hstep, voffA);
            PG8_WAIT_V(8); PG8_WAIT_L(0); PG8_BAR; PG8_MMA(0, 0, At, B0); PG8_MMA(0, 1, At, B1); PG8_BAR; PG8_SCHED;
            PG8_LDA(At, 0, 1); PG8_STAGE(PG8_SB(0, 0), b2, voffB); PG8_STAGE(PG8_SB(0, 1), b2 + hstep, voffB); PG8_STAGE(PG8_SA(0, 0), a2, voffA);
            PG8_WAIT_V(8); PG8_WAIT_L(0); PG8_BAR; PG8_MMA(1, 0, At, B0); PG8_MMA(1, 1, At, B1); PG8_BAR; PG8_SCHED;
            PG8_LDB(B0, 1, 0); PG8_LDB(B1, 1, 1); PG8_SCHED; PG8_LDA(At, 1, 0); PG8_STAGE(PG8_SA(0, 1), a2 + hstep, voffA);
            PG8_WAIT_V(8); PG8_WAIT_L(0); PG8_BAR; PG8_MMA(0, 0, At, B0); PG8_MMA(0, 1, At, B1); PG8_BAR; PG8_SCHED;
            PG8_LDA(At, 1, 1); PG8_STAGE(PG8_SB(1, 0), b3, voffB); PG8_STAGE(PG8_SB(1, 1), b3 + hstep, voffB); PG8_STAGE(PG8_SA(1, 0), a3, voffA);
            PG8_WAIT_V(8); PG8_WAIT_L(0); PG8_BAR; PG8_MMA(1, 0, At, B0); PG8_MMA(1, 1, At, B1); PG8_BAR; PG8_SCHED;
            } else {
            PG8_LDB(B0, 0, 0); PG8_SCHED; PG8_LDA(At, 0, 0); PG8_STAGE(PG8_SA(1, 1), a1 + hstep, voffA);
            PG8_WAIT_L(8); PG8_BAR; PG8_WAIT_L(0); PG8_MMA(0, 0, At, B0); PG8_BAR; PG8_SCHED;
            PG8_LDB(B1, 0, 1); PG8_STAGE(PG8_SB(0, 0), b2, voffB);
            PG8_BAR; PG8_WAIT_L(0); PG8_MMA(0, 1, At, B1); PG8_BAR;
            PG8_LDA(At, 0, 1); PG8_STAGE(PG8_SA(0, 0), a2, voffA);
            PG8_BAR; PG8_WAIT_L(0); PG8_MMA(1, 0, At, B0); PG8_BAR; PG8_SCHED;
            PG8_STAGE(PG8_SB(0, 1), b2 + hstep, voffB);
            PG8_WAIT_V(6); PG8_BAR; PG8_MMA(1, 1, At, B1); PG8_BAR;
            PG8_LDB(B0, 1, 0); PG8_SCHED; PG8_LDA(At, 1, 0); PG8_STAGE(PG8_SA(0, 1), a2 + hstep, voffA);
            PG8_WAIT_L(8); PG8_BAR; PG8_WAIT_L(0); PG8_MMA(0, 0, At, B0); PG8_BAR; PG8_SCHED;
            PG8_LDB(B1, 1, 1); PG8_STAGE(PG8_SB(1, 0), b3, voffB);
            PG8_BAR; PG8_WAIT_L(0); PG8_MMA(0, 1, At, B1); PG8_BAR;
            PG8_LDA(At, 1, 1); PG8_STAGE(PG8_SA(1, 0), a3, voffA);
            PG8_BAR; PG8_WAIT_L(0); PG8_MMA(1, 0, At, B0); PG8_BAR; PG8_SCHED;
            PG8_STAGE(PG8_SB(1, 1), b3 + hstep, voffB);
            PG8_WAIT_V(6); PG8_BAR; PG8_MMA(1, 1, At, B1); PG8_BAR;
            }
        }
        if constexpr (ALIGN_EPI) { if (wr == 0) PG8_BAR; }
        if constexpr (!Epi::AFTER_DRAIN) { E(acc, cur, wr, wc, fr, fq); S.done(cur); }
        if (!has_next) break;
#pragma unroll
        for (int a = 0; a < 2; ++a)
#pragma unroll
            for (int b = 0; b < 2; ++b)
#pragma unroll
                for (int m = 0; m < 4; ++m)
#pragma unroll
                    for (int n = 0; n < 2; ++n) acc[a][b][m][n] = (f32x4){0.f, 0.f, 0.f, 0.f};
        cur = nxt; cA = nA; cB = nB; ++ui;
        if constexpr (ALIGN_EPI) { if (wr == 1) PG8_BAR; }
    }
    PG8_WAIT_V(0);
    if constexpr (!ALIGN_EPI) { if (wr == 0) PG8_BAR; }
    PG8_BAR;
    if constexpr (Epi::AFTER_DRAIN) { E.fused(acc, cur, wr, wc, fr, fq, lds, wid, lane); S.done(cur); }
#undef PG8_SA
#undef PG8_SB
#undef PG8_STAGE
#undef PG8_LDA
#undef PG8_LDB
#undef PG8_MMA
#undef PG8_WAIT_V
#undef PG8_WAIT_L
#undef PG8_BAR
#undef PG8_SCHED
}
}

constexpr int BATCH = 4, SEQ = 8192, DM = 1024, TOK = BATCH * SEQ;
constexpr int P0W = 2304, P1W = 3072;
constexpr float EPS = 1e-6f, LOG2E = 1.4426950408889634f;
constexpr size_t MiB = 1u << 20;
constexpr size_t WS_WIN0 = 0, WS_WOUT0 = 5 * MiB, WS_WIN1 = 7 * MiB, WS_WOUT1 = 13 * MiB, WS_POOL = 15 * MiB;
constexpr size_t WS_H = 16 * MiB;
constexpr size_t WS_Y = 80 * MiB;
constexpr size_t WS_PROJ = 144 * MiB;
constexpr size_t WS_END = 336 * MiB;
constexpr int LDS_BYTES = 147456;
#ifndef N_LAUNCH_MODE
#define N_LAUNCH_MODE 1
#endif
#ifndef REP0
#define REP0 1
#endif
#ifndef REP1
#define REP1 1
#endif
#ifndef REP2
#define REP2 1
#endif
#ifndef REP3
#define REP3 1
#endif
#ifndef REP4
#define REP4 1
#endif
#ifndef REP5
#define REP5 1
#endif
#ifndef REP6
#define REP6 1
#endif
#ifndef REP7
#define REP7 1
#endif
#ifndef CONV_REP
#define CONV_REP 1
#endif
constexpr int NPHASE = 9;

typedef unsigned short bf16;
typedef short bf16x8 __attribute__((ext_vector_type(8)));
typedef short s16x4 __attribute__((ext_vector_type(4)));
typedef float f32x16 __attribute__((ext_vector_type(16)));
typedef float f32x4 __attribute__((ext_vector_type(4)));
typedef float f32x2 __attribute__((ext_vector_type(2)));
typedef unsigned u32x4 __attribute__((ext_vector_type(4)));
typedef unsigned u32x2 __attribute__((ext_vector_type(2)));
typedef __bf16 bf16x2_t __attribute__((ext_vector_type(2)));

__device__ __forceinline__ float bflo(unsigned u) { return __uint_as_float(u << 16); }
__device__ __forceinline__ float bfhi(unsigned u) { return __uint_as_float(u & 0xffff0000u); }
__device__ __forceinline__ unsigned pk2(float lo, float hi) { f32x2 v = {lo, hi}; bf16x2_t b = __builtin_convertvector(v, bf16x2_t); return __builtin_bit_cast(unsigned, b); }
__device__ __forceinline__ float wave_sum(float v) {
#pragma unroll
    for (int o = 1; o < 64; o <<= 1) v += __shfl_xor(v, o);
    return v;
}
__device__ __forceinline__ float sigm(float x) { return __builtin_amdgcn_rcpf(1.f + __builtin_amdgcn_exp2f(-x * LOG2E)); }
__device__ __forceinline__ float silu(float x) { return x * sigm(x); }
#define LDS_WAIT() asm volatile("s_waitcnt lgkmcnt(0)" ::: "memory")

__device__ __forceinline__ void transpose_item(const float* __restrict__ W, int K, int N, bf16* __restrict__ WT, int row_off, float* scr, int item, int lane) {
    const int nblk = N / 32, kb = item / nblk, nb = item % nblk, k0 = 64 * kb, n0 = 32 * nb;
#pragma unroll
    for (int i = 0; i < 32; ++i) { const int kk = 2 * i + (lane >> 5); scr[kk * 33 + (lane & 31)] = W[(size_t)(k0 + kk) * N + n0 + (lane & 31)]; }
    LDS_WAIT();
    const int c = lane & 7;
#pragma unroll
    for (int j = 0; j < 4; ++j) { const int n = (lane >> 3) + 8 * j; const float* s = scr + (8 * c) * 33 + n;
        u32x4 o; o.x = pk2(s[0 * 33], s[1 * 33]); o.y = pk2(s[2 * 33], s[3 * 33]); o.z = pk2(s[4 * 33], s[5 * 33]); o.w = pk2(s[6 * 33], s[7 * 33]);
        *(u32x4*)(WT + (size_t)(row_off + n0 + n) * K + k0 + 8 * c) = o; }
    LDS_WAIT();
}
__device__ __forceinline__ void norm_row_bf16(const float* __restrict__ xrow, const float* __restrict__ g, bf16* __restrict__ orow, int lane) {
    const f32x4* xr = (const f32x4*)xrow + lane; const f32x4* gr = (const f32x4*)g + lane;
    f32x4 v[4]; float s = 0.f;
#pragma unroll
    for (int j = 0; j < 4; ++j) { v[j] = xr[64 * j]; s += (v[j].x * v[j].x + v[j].y * v[j].y) + (v[j].z * v[j].z + v[j].w * v[j].w); }
    const float r = 1.0f / sqrtf(wave_sum(s) * (1.f / DM) + EPS);
    u32x2* o8 = (u32x2*)orow + lane;
#pragma unroll
    for (int j = 0; j < 4; ++j) { const f32x4 gv = gr[64 * j]; u32x2 o; o.x = pk2(v[j].x * r * gv.x, v[j].y * r * gv.y); o.y = pk2(v[j].z * r * gv.z, v[j].w * r * gv.w); o8[64 * j] = o; }
}
__device__ __forceinline__ void resid_row(const float* xrow, const bf16* __restrict__ yrow, const float* __restrict__ gpost, const float* __restrict__ gpre, float* x1row, bf16* __restrict__ hrow, int lane) {
    const u32x2* yr = (const u32x2*)yrow + lane; const f32x4* xr = (const f32x4*)xrow + lane; const f32x4* gp = (const f32x4*)gpost + lane;
    f32x4 y[4]; float s = 0.f;
#pragma unroll
    for (int j = 0; j < 4; ++j) { const u32x2 u = yr[64 * j]; y[j] = (f32x4){bflo(u.x), bfhi(u.x), bflo(u.y), bfhi(u.y)};
        s += (y[j].x * y[j].x + y[j].y * y[j].y) + (y[j].z * y[j].z + y[j].w * y[j].w); }
    const float r = 1.0f / sqrtf(wave_sum(s) * (1.f / DM) + EPS);
    f32x4 x1[4]; float s2 = 0.f;
#pragma unroll
    for (int j = 0; j < 4; ++j) { const f32x4 xv = xr[64 * j]; const f32x4 gv = gp[64 * j]; x1[j] = xv + y[j] * r * gv;
        s2 += (x1[j].x * x1[j].x + x1[j].y * x1[j].y) + (x1[j].z * x1[j].z + x1[j].w * x1[j].w); }
    f32x4* xo = (f32x4*)x1row + lane;
#pragma unroll
    for (int j = 0; j < 4; ++j) xo[64 * j] = x1[j];
    if (hrow) {
        const float r2 = 1.0f / sqrtf(wave_sum(s2) * (1.f / DM) + EPS);
        const f32x4* gq = (const f32x4*)gpre + lane; u32x2* o8 = (u32x2*)hrow + lane;
#pragma unroll
        for (int j = 0; j < 4; ++j) { const f32x4 gv = gq[64 * j]; u32x2 o; o.x = pk2(x1[j].x * r2 * gv.x, x1[j].y * r2 * gv.y); o.y = pk2(x1[j].z * r2 * gv.z, x1[j].w * r2 * gv.w); o8[64 * j] = o; }
    }
}

template <int NR> __device__ __forceinline__ void norm_rows_bf16(const float* __restrict__ xrow, const float* __restrict__ g, bf16* __restrict__ orow, int lane) {
    f32x4 v[NR][4]; float s[NR];
#pragma unroll
    for (int q = 0; q < NR; ++q) { const f32x4* xr = (const f32x4*)(xrow + (size_t)q * DM) + lane;
#pragma unroll
        for (int j = 0; j < 4; ++j) v[q][j] = xr[64 * j]; }
#pragma unroll
    for (int q = 0; q < NR; ++q) { float a = 0.f;
#pragma unroll
        for (int j = 0; j < 4; ++j) a += (v[q][j].x * v[q][j].x + v[q][j].y * v[q][j].y) + (v[q][j].z * v[q][j].z + v[q][j].w * v[q][j].w);
        s[q] = a; }
#pragma unroll
    for (int o = 1; o < 64; o <<= 1) {
#pragma unroll
        for (int q = 0; q < NR; ++q) s[q] += __shfl_xor(s[q], o); }
    const f32x4* gr = (const f32x4*)g + lane; f32x4 gv[4];
#pragma unroll
    for (int j = 0; j < 4; ++j) gv[j] = gr[64 * j];
#pragma unroll
    for (int q = 0; q < NR; ++q) { const float r = 1.0f / sqrtf(s[q] * (1.f / DM) + EPS); u32x2* o8 = (u32x2*)(orow + (size_t)q * DM) + lane;
#pragma unroll
        for (int j = 0; j < 4; ++j) { u32x2 o; o.x = pk2(v[q][j].x * r * gv[j].x, v[q][j].y * r * gv[j].y); o.y = pk2(v[q][j].z * r * gv[j].z, v[q][j].w * r * gv[j].w); o8[64 * j] = o; } }
}
template <int NR, bool WITH_H> __device__ __forceinline__ void resid_rows(const float* xrow, const bf16* __restrict__ yrow, const float* __restrict__ gpost, const float* __restrict__ gpre, float* x1row, bf16* __restrict__ hrow, int lane) {
    f32x4 y[NR][4], x1[NR][4]; float s[NR];
#pragma unroll
    for (int q = 0; q < NR; ++q) { const u32x2* yr = (const u32x2*)(yrow + (size_t)q * DM) + lane; const f32x4* xr = (const f32x4*)(xrow + (size_t)q * DM) + lane;
#pragma unroll
        for (int j = 0; j < 4; ++j) { const u32x2 u = yr[64 * j]; y[q][j] = (f32x4){bflo(u.x), bfhi(u.x), bflo(u.y), bfhi(u.y)}; x1[q][j] = xr[64 * j]; } }
#pragma unroll
    for (int q = 0; q < NR; ++q) { float a = 0.f;
#pragma unroll
        for (int j = 0; j < 4; ++j) a += (y[q][j].x * y[q][j].x + y[q][j].y * y[q][j].y) + (y[q][j].z * y[q][j].z + y[q][j].w * y[q][j].w);
        s[q] = a; }
#pragma unroll
    for (int o = 1; o < 64; o <<= 1) {
#pragma unroll
        for (int q = 0; q < NR; ++q) s[q] += __shfl_xor(s[q], o); }
    { const f32x4* gp = (const f32x4*)gpost + lane; f32x4 gv[4];
#pragma unroll
      for (int j = 0; j < 4; ++j) gv[j] = gp[64 * j];
#pragma unroll
      for (int q = 0; q < NR; ++q) { const float r = 1.0f / sqrtf(s[q] * (1.f / DM) + EPS); f32x4* xo = (f32x4*)(x1row + (size_t)q * DM) + lane; float a = 0.f;
#pragma unroll
        for (int j = 0; j < 4; ++j) { x1[q][j] = x1[q][j] + y[q][j] * r * gv[j]; xo[64 * j] = x1[q][j];
            a += (x1[q][j].x * x1[q][j].x + x1[q][j].y * x1[q][j].y) + (x1[q][j].z * x1[q][j].z + x1[q][j].w * x1[q][j].w); }
        s[q] = a; } }
    if (WITH_H) {
#pragma unroll
        for (int o = 1; o < 64; o <<= 1) {
#pragma unroll
            for (int q = 0; q < NR; ++q) s[q] += __shfl_xor(s[q], o); }
        const f32x4* gq = (const f32x4*)gpre + lane; f32x4 gv[4];
#pragma unroll
        for (int j = 0; j < 4; ++j) gv[j] = gq[64 * j];
#pragma unroll
        for (int q = 0; q < NR; ++q) { const float r2 = 1.0f / sqrtf(s[q] * (1.f / DM) + EPS); u32x2* o8 = (u32x2*)(hrow + (size_t)q * DM) + lane;
#pragma unroll
            for (int j = 0; j < 4; ++j) { u32x2 o; o.x = pk2(x1[q][j].x * r2 * gv[j].x, x1[q][j].y * r2 * gv[j].y); o.y = pk2(x1[q][j].z * r2 * gv[j].z, x1[q][j].w * r2 * gv[j].w); o8[64 * j] = o; } }
    }
}

constexpr int KS_LD = 72, VT_LD = 260, KS_BYTES = 256 * KS_LD * 2;
struct KVRegs { u32x4 k[4], v[4]; };
__device__ __forceinline__ void attn_load(const bf16* __restrict__ proj, int unit, int tid, KVRegs& R) {
    const int kvh = unit & 1, n = (unit >> 1) & 63, b = unit >> 7;
    const long tok0 = (long)b * SEQ + n * 128;
#pragma unroll
    for (int i = 0; i < 4; ++i) {
        const int id = i * 512 + tid, row = id >> 3, c = id & 7;
        const bool ok = (n > 0) || (i >= 2);
        const bf16* src = proj + (ok ? (tok0 - 128 + row) : tok0) * P0W + kvh * 64 + c * 8;
        const u32x4 kv = *(const u32x4*)(src + 512), vv = *(const u32x4*)(src + 640);
        R.k[i] = ok ? kv : (u32x4){0u, 0u, 0u, 0u}; R.v[i] = ok ? vv : (u32x4){0u, 0u, 0u, 0u};
    }
}
__device__ __forceinline__ void attn_store(unsigned char* lds, int tid, const KVRegs& R) {
    bf16* Ks = (bf16*)lds; bf16* Vt = (bf16*)(lds + KS_BYTES);
#pragma unroll
    for (int i = 0; i < 4; ++i) {
        const int id = i * 512 + tid, row = id >> 3, c = id & 7;
        *(u32x4*)(Ks + row * KS_LD + c * 8) = R.k[i];
        const u32x4 vv = R.v[i];
        bf16* vd = Vt + (c * 8) * VT_LD + row;
        vd[0 * VT_LD] = (bf16)(vv.x & 0xffffu); vd[1 * VT_LD] = (bf16)(vv.x >> 16);
        vd[2 * VT_LD] = (bf16)(vv.y & 0xffffu); vd[3 * VT_LD] = (bf16)(vv.y >> 16);
        vd[4 * VT_LD] = (bf16)(vv.z & 0xffffu); vd[5 * VT_LD] = (bf16)(vv.z >> 16);
        vd[6 * VT_LD] = (bf16)(vv.w & 0xffffu); vd[7 * VT_LD] = (bf16)(vv.w >> 16);
    }
}
__device__ __forceinline__ void attn_phase(const bf16* __restrict__ proj, bf16* __restrict__ mix, const float* __restrict__ sinks, unsigned char* lds, int bid, int G, int tid) {
    const int lane = tid & 63, wid = tid >> 6, r32 = lane & 31, hi = lane >> 5;
    const bf16* Ks = (const bf16*)lds; const bf16* Vt = (const bf16*)(lds + KS_BYTES);
    const int g = wid >> 1, qh = wid & 1;
    const float SC2 = 0.125f * LOG2E;
    KVRegs R;
    int unit = bid;
    if (unit < 512) attn_load(proj, unit, tid, R);
#pragma unroll 1
    for (; unit < 512; unit += G) {
        const int kvh = unit & 1, n = (unit >> 1) & 63, b = unit >> 7;
        const long tok0 = (long)b * SEQ + n * 128;
        const int hq = kvh * 4 + g;
        const float slope2 = __builtin_amdgcn_exp2f(-(float)(hq + 1)) * LOG2E;
        const float sink2 = sinks[hq] * LOG2E;
        bf16x8 qf[4];
        { const bf16* qp = proj + (tok0 + qh * 64 + r32) * P0W + hq * 64 + hi * 8;
#pragma unroll
          for (int ds = 0; ds < 4; ++ds) qf[ds] = *(const bf16x8*)(qp + ds * 16); }
        attn_store(lds, tid, R);
        __syncthreads();
        if (unit + G < 512) attn_load(proj, unit + G, tid, R);
#pragma unroll
        for (int sub = 0; sub < 2; ++sub) {
            const int q0 = qh * 64 + sub * 32;
            const long tok = tok0 + q0 + r32;
            u32x2 gu[8];
            { const bf16* gap = proj + tok * P0W + 768 + hq * 64 + 4 * hi;
#pragma unroll
              for (int i = 0; i < 8; ++i) gu[i] = *(const u32x2*)(gap + 8 * i); }
            bf16x8 qn[4];
            if (sub == 0) { const bf16* qp = proj + (tok + 32) * P0W + hq * 64 + hi * 8;
#pragma unroll
                for (int ds = 0; ds < 4; ++ds) qn[ds] = *(const bf16x8*)(qp + ds * 16); }
            f32x16 s[5];
#pragma unroll
            for (int kt = 0; kt < 5; ++kt) {
                f32x16 acc = {0.f, 0.f, 0.f, 0.f, 0.f, 0.f, 0.f, 0.f, 0.f, 0.f, 0.f, 0.f, 0.f, 0.f, 0.f, 0.f};
                const bf16* kp = Ks + (q0 + 32 * kt + r32) * KS_LD + hi * 8;
#pragma unroll
                for (int ds = 0; ds < 4; ++ds) acc = __builtin_amdgcn_mfma_f32_32x32x16_bf16(*(const bf16x8*)(kp + ds * 16), qf[ds], acc, 0, 0, 0);
                s[kt] = acc;
                __builtin_amdgcn_sched_barrier(0);
            }
            float mx = sink2;
            {
                int base_i = 128 + r32 - 4 * hi;
                int lo_i = (n > 0) ? (base_i - 128) : max(base_i - 128, 127 - q0 - 4 * hi);
                float sbf = slope2 * (float)base_i;
                asm volatile("" : "+v"(base_i), "+v"(lo_i), "+v"(sbf));
#pragma unroll
                for (int kt = 0; kt < 5; ++kt)
#pragma unroll
                    for (int r = 0; r < 16; ++r) {
                        const int cc = 32 * kt + (r & 3) + 8 * (r >> 2);
                        const bool valid = (cc <= base_i) && (cc > lo_i);
                        const float bias = fmaf(slope2, (float)cc, -sbf);
                        const float v = valid ? fmaf(s[kt][r], SC2, bias) : -INFINITY;
                        s[kt][r] = v; mx = fmaxf(mx, v);
                    }
            }
            mx = fmaxf(mx, __shfl_xor(mx, 32));
            float sum = 0.f;
#pragma unroll
            for (int kt = 0; kt < 5; ++kt)
#pragma unroll
                for (int r = 0; r < 16; ++r) { const float p = __builtin_amdgcn_exp2f(s[kt][r] - mx); s[kt][r] = p; sum += p; }
            sum += __shfl_xor(sum, 32);
            const float inv = 1.0f / (sum + __builtin_amdgcn_exp2f(sink2 - mx));
            f32x16 ot[2];
#pragma unroll
            for (int dt = 0; dt < 2; ++dt) ot[dt] = (f32x16){0.f, 0.f, 0.f, 0.f, 0.f, 0.f, 0.f, 0.f, 0.f, 0.f, 0.f, 0.f, 0.f, 0.f, 0.f, 0.f};
#pragma unroll
            for (int kt = 0; kt < 5; ++kt)
#pragma unroll
                for (int si = 0; si < 2; ++si) {
                    u32x4 pw; pw.x = pk2(s[kt][8 * si + 0], s[kt][8 * si + 1]); pw.y = pk2(s[kt][8 * si + 2], s[kt][8 * si + 3]);
                    pw.z = pk2(s[kt][8 * si + 4], s[kt][8 * si + 5]); pw.w = pk2(s[kt][8 * si + 6], s[kt][8 * si + 7]);
                    const bf16x8 pf = __builtin_bit_cast(bf16x8, pw);
                    const int kb = q0 + 32 * kt + 16 * si + 4 * hi;
#pragma unroll
                    for (int dt = 0; dt < 2; ++dt) {
                        const bf16* vp = Vt + (dt * 32 + r32) * VT_LD + kb;
                        const s16x4 lo4 = *(const s16x4*)vp, hi4 = *(const s16x4*)(vp + 8);
                        const bf16x8 vf = {lo4[0], lo4[1], lo4[2], lo4[3], hi4[0], hi4[1], hi4[2], hi4[3]};
                        ot[dt] = __builtin_amdgcn_mfma_f32_32x32x16_bf16(vf, pf, ot[dt], 0, 0, 0);
                    }
                    __builtin_amdgcn_sched_barrier(0);
                }
            bf16* op = mix + tok * DM + hq * 64 + 4 * hi;
#pragma unroll
            for (int dt = 0; dt < 2; ++dt)
#pragma unroll
                for (int rg = 0; rg < 4; ++rg) {
                    const u32x2 gv = gu[4 * dt + rg];
                    u32x2 o;
                    o.x = pk2(ot[dt][4 * rg + 0] * inv * silu(bflo(gv.x)), ot[dt][4 * rg + 1] * inv * silu(bfhi(gv.x)));
                    o.y = pk2(ot[dt][4 * rg + 2] * inv * silu(bflo(gv.y)), ot[dt][4 * rg + 3] * inv * silu(bfhi(gv.y)));
                    *(u32x2*)(op + 32 * dt + 8 * rg) = o;
                }
            if (sub == 0) {
#pragma unroll
                for (int ds = 0; ds < 4; ++ds) qf[ds] = qn[ds];
            }
        }
        __syncthreads();
    }
}

constexpr int U_LD = 128, PL_LD = 136, U_BYTES = 144 * U_LD * 2;
struct URegs { u32x4 v[5]; };
template <int W> __device__ __forceinline__ void pooled_chunk(const bf16* U, bf16* Pl, int t0, int cp, int n) {
    float lo[31], hi[31];
#pragma unroll
    for (int r = 0; r < 31; ++r) { const unsigned u = *(const unsigned*)(U + (t0 + 1 + r) * U_LD + 2 * cp); lo[r] = bflo(u); hi[r] = bfhi(u); }
    float s0 = 0.f, s1 = 0.f;
#pragma unroll
    for (int i = 1; i < W; ++i) { s0 += lo[15 - i]; s1 += hi[15 - i]; }
#pragma unroll
    for (int tt = 0; tt < 16; ++tt) {
        s0 += lo[15 + tt]; s1 += hi[15 + tt];
        const int pos = n * 128 + t0 + tt; const int cnt = (pos + 1 < W) ? (pos + 1) : W; const float ic = 1.0f / (float)cnt;
        *(unsigned*)(Pl + (t0 + tt) * PL_LD + 2 * cp) = pk2(s0 * ic - lo[15 + tt], s1 * ic - hi[15 + tt]);
        s0 -= lo[15 + tt - (W - 1)]; s1 -= hi[15 + tt - (W - 1)];
    }
}
__device__ __forceinline__ void pool_load(const bf16* __restrict__ proj, int unit, int tid, URegs& R) {
    const int g = unit >> 8, n = unit & 63, b = (unit >> 6) & 3;
    const long tok0 = (long)b * SEQ + n * 128;
#pragma unroll
    for (int i = 0; i < 5; ++i) {
        const int id = i * 512 + tid, row = id >> 4, c = id & 15;
        if (i < 4 || tid < 256) {
            const bool ok = (n > 0) || (row >= 16);
            const u32x4 v = *(const u32x4*)(proj + (ok ? (tok0 - 16 + row) : tok0) * P0W + 1280 + g * 128 + c * 8);
            R.v[i] = ok ? v : (u32x4){0u, 0u, 0u, 0u};
        }
    }
}
__device__ __forceinline__ void pool_phase(const bf16* __restrict__ proj, bf16* __restrict__ mix, const bf16* __restrict__ poolT, const float* __restrict__ pscale, unsigned char* lds, int bid, int G, int tid) {
    const int lane = tid & 63, wid = tid >> 6, r32 = lane & 31, hi = lane >> 5;
    bf16* U = (bf16*)lds;
    bf16* Pl = (bf16*)(lds + U_BYTES);
    URegs R;
    int unit = bid;
    if (unit < 1024) pool_load(proj, unit, tid, R);
#pragma unroll 1
    for (; unit < 1024; unit += G) {
        const int g = unit >> 8, n = unit & 63, b = (unit >> 6) & 3;
        const long tok0 = (long)b * SEQ + n * 128;
#pragma unroll
        for (int i = 0; i < 5; ++i) { const int id = i * 512 + tid, row = id >> 4, c = id & 15; if (i < 4 || tid < 256) *(u32x4*)(U + row * U_LD + c * 8) = R.v[i]; }
        __syncthreads();
        if (unit + G < 1024) pool_load(proj, unit + G, tid, R);
        const int tt = wid >> 1, dbase = (wid & 1) * 64;
        const long tok = tok0 + tt * 32 + r32;
        u32x2 gu[8]; f32x4 sc[8];
        { const bf16* gbp = proj + tok * P0W + 1792 + g * 128 + dbase + 4 * hi; const float* scp = pscale + g * 128 + dbase + 4 * hi;
#pragma unroll
          for (int i = 0; i < 8; ++i) { gu[i] = *(const u32x2*)(gbp + 8 * i); sc[i] = *(const f32x4*)(scp + 8 * i); } }
        {
            const int cp = tid & 63, t0 = (tid >> 6) * 16;
            if (g == 0) pooled_chunk<2>(U, Pl, t0, cp, n); else if (g == 1) pooled_chunk<4>(U, Pl, t0, cp, n);
            else if (g == 2) pooled_chunk<8>(U, Pl, t0, cp, n); else pooled_chunk<16>(U, Pl, t0, cp, n);
        }
        __syncthreads();
#pragma unroll
        for (int dti = 0; dti < 2; ++dti) {
            const int dt0 = dbase + dti * 32;
            f32x16 acc = {0.f, 0.f, 0.f, 0.f, 0.f, 0.f, 0.f, 0.f, 0.f, 0.f, 0.f, 0.f, 0.f, 0.f, 0.f, 0.f};
            const bf16* ap = poolT + (size_t)(g * 128 + dt0 + r32) * 128 + hi * 8;
            const bf16* bp = Pl + (tt * 32 + r32) * PL_LD + hi * 8;
#pragma unroll
            for (int ks = 0; ks < 8; ++ks) acc = __builtin_amdgcn_mfma_f32_32x32x16_bf16(*(const bf16x8*)(ap + ks * 16), *(const bf16x8*)(bp + ks * 16), acc, 0, 0, 0);
            bf16* op = mix + tok * DM + 512 + g * 128 + dt0 + 4 * hi;
#pragma unroll
            for (int rg = 0; rg < 4; ++rg) {
                const u32x2 gv = gu[4 * dti + rg]; const f32x4 sv = sc[4 * dti + rg];
                u32x2 o;
                o.x = pk2(acc[4 * rg + 0] * sv.x * silu(bflo(gv.x)), acc[4 * rg + 1] * sv.y * silu(bfhi(gv.x)));
                o.y = pk2(acc[4 * rg + 2] * sv.z * silu(bflo(gv.y)), acc[4 * rg + 3] * sv.w * silu(bfhi(gv.y)));
                *(u32x2*)(op + 8 * rg) = o;
            }
        }
    }
    __syncthreads();
}

namespace pg8 {
struct EpiGlu {
    static constexpr bool PERM = true, AFTER_DRAIN = false;
    bf16_t* O;
    __device__ __forceinline__ void operator()(const f32x4 (&acc)[2][2][4][2], const Unit& u, int wr, int wc, int fr, int fq) const {
        const int row0 = u.pm * BM + wr * 64 + fr;
        if (u.pn < 8) {
            const int col0 = u.pn * 128 + wc * 32 + 8 * fq;
#pragma unroll
            for (int ai = 0; ai < 2; ++ai)
#pragma unroll
                for (int m = 0; m < 4; ++m) {
                    bf16_t* rowp = O + (size_t)(row0 + ai * HALF + m * 16) * 2048 + col0;
                    const f32x4 a0 = acc[ai][0][m][0], a1 = acc[ai][0][m][1], b0 = acc[ai][1][m][0], b1 = acc[ai][1][m][1];
                    u32x4 w;
                    w.x = ::pk2(a0[0] * ::sigm(b0[0]), a0[1] * ::sigm(b0[1])); w.y = ::pk2(a0[2] * ::sigm(b0[2]), a0[3] * ::sigm(b0[3]));
                    w.z = ::pk2(a1[0] * ::sigm(b1[0]), a1[1] * ::sigm(b1[1])); w.w = ::pk2(a1[2] * ::sigm(b1[2]), a1[3] * ::sigm(b1[3]));
                    *(u32x4*)rowp = w;
                }
        } else {
            const int col0 = 1024 + (u.pn - 8) * 256 + wc * 32 + 8 * fq;
#pragma unroll
            for (int ai = 0; ai < 2; ++ai)
#pragma unroll
                for (int m = 0; m < 4; ++m) {
                    bf16_t* rowp = O + (size_t)(row0 + ai * HALF + m * 16) * 2048 + col0;
#pragma unroll
                    for (int bj = 0; bj < 2; ++bj) {
                        const f32x4 v0 = acc[ai][bj][m][0], v1 = acc[ai][bj][m][1];
                        u32x4 w;
                        w.x = ::pk2(::silu(v0[0]), ::silu(v0[1])); w.y = ::pk2(::silu(v0[2]), ::silu(v0[3]));
                        w.z = ::pk2(::silu(v1[0]), ::silu(v1[1])); w.w = ::pk2(::silu(v1[2]), ::silu(v1[3]));
                        *(u32x4*)(rowp + bj * HALF) = w;
                    }
                }
        }
    }
};
}

constexpr int GLW = 2048;
template <bool CHECK> __device__ __forceinline__ void conv_accum(f32x2 (&acc)[16], const f32x2 (&w)[31], const unsigned* gbase, int p0) {
#pragma unroll
    for (int j = 0; j < 46; ++j) {
        f32x2 x = {0.f, 0.f};
        if (!CHECK || p0 + j >= 30) { const unsigned u = gbase[(j - 30) * (GLW / 2)]; x = (f32x2){bflo(u), bfhi(u)}; }
#pragma unroll
        for (int t = 0; t < 16; ++t) { const int k = j - t; if (k >= 0 && k <= 30) acc[t] = __builtin_elementwise_fma(x, w[k], acc[t]); }
    }
}
__device__ __forceinline__ void conv_phase(const bf16* __restrict__ gl, bf16* __restrict__ z, const float* __restrict__ dww, const float* __restrict__ dwb,
                                          const float* __restrict__ lng, const float* __restrict__ lnb, unsigned char* lds, int bid, int G, int tid) {
    const int lane = tid & 63, wid = tid >> 6;
    float* red = (float*)lds;
    float* stat = (float*)(lds + 1024);
    f32x2 w[31];
#pragma unroll
    for (int k = 0; k < 31; ++k) { const f32x2* wp = (const f32x2*)(dww + k * 1024); w[k] = wp[tid]; }
    const f32x2 bias = ((const f32x2*)dwb)[tid], gg = ((const f32x2*)lng)[tid], bb2 = ((const f32x2*)lnb)[tid];
#pragma unroll 1
    for (int unit_ = bid; unit_ < CONV_REP * (TOK / 16); unit_ += G) {
    const int unit = unit_ % (TOK / 16);
    const long tok0 = (long)unit * 16; const int p0 = (int)(tok0 & (SEQ - 1));
    const unsigned* gbase = (const unsigned*)(gl + tok0 * GLW) + tid;
    unsigned* zbase = (unsigned*)(z + tok0 * DM) + tid;
    asm volatile("" : "+v"(gbase), "+v"(zbase));
    f32x2 acc[16];
#pragma unroll
    for (int t = 0; t < 16; ++t) acc[t] = bias;
    if (p0 >= 32) conv_accum<false>(acc, w, gbase, p0); else conv_accum<true>(acc, w, gbase, p0);
    unsigned ug[16];
#pragma unroll
    for (int t = 0; t < 16; ++t) ug[t] = gbase[t * (GLW / 2) + 512];
    {
        float v[32];
#pragma unroll
        for (int t = 0; t < 16; ++t) { const float a0 = acc[t].x, a1 = acc[t].y; v[2 * t] = a0 + a1; v[2 * t + 1] = a0 * a0 + a1 * a1; }
#pragma unroll
        for (int step = 0; step < 5; ++step) {
            const int half = 16 >> step; const bool up = (lane >> step) & 1;
#pragma unroll
            for (int i = 0; i < half; ++i) { const float va = v[i], vb = v[i + half]; const float send = up ? va : vb; const float keep = up ? vb : va; v[i] = keep + __shfl_xor(send, 1 << step); }
        }
        v[0] += __shfl_xor(v[0], 32);
        const int idx = ((lane & 1) << 4) | ((lane & 2) << 2) | (lane & 4) | ((lane & 8) >> 2) | ((lane & 16) >> 4);
        if (lane < 32) red[wid * 32 + idx] = v[0];
    }
    __syncthreads();
    if (tid < 16) {
        float s1 = 0.f, s2 = 0.f;
#pragma unroll
        for (int ww = 0; ww < 8; ++ww) { s1 += red[ww * 32 + 2 * tid]; s2 += red[ww * 32 + 2 * tid + 1]; }
        const float mu = s1 * (1.f / 1024.f); float var = s2 * (1.f / 1024.f) - mu * mu; var = var > 0.f ? var : 0.f;
        stat[2 * tid] = mu; stat[2 * tid + 1] = 1.0f / sqrtf(var + EPS);
    }
    __syncthreads();
#pragma unroll
    for (int t = 0; t < 16; ++t) {
        const float mu = stat[2 * t], rs = stat[2 * t + 1];
        const float cn0 = (acc[t].x - mu) * rs * gg.x + bb2.x, cn1 = (acc[t].y - mu) * rs * gg.y + bb2.y;
        zbase[t * (DM / 2)] = pk2(silu(cn0) * bflo(ug[t]), silu(cn1) * bfhi(ug[t]));
    }
    }
    __syncthreads();
}

struct Args { const float* in[14]; float* out; unsigned char* ws; int ph_lo, ph_hi; };
__global__ void __launch_bounds__(512, 2) fwd_kernel(Args a) {
    extern __shared__ __attribute__((aligned(16))) unsigned char lds[];
    cg::grid_group grid = cg::this_grid();
    const int tid = threadIdx.x, lane = tid & 63, wid = __builtin_amdgcn_readfirstlane(tid >> 6);
    const int G = gridDim.x, bid = blockIdx.x;
    const int gw = bid * 8 + wid, NGW = G * 8;
    const int lo = a.ph_lo, hi = a.ph_hi;
    unsigned char* ws = a.ws;
    const float* x = a.in[0]; const float* pre_norm = a.in[1]; const float* post_norm = a.in[2];
    bf16* Win0 = (bf16*)(ws + WS_WIN0); bf16* Wout0 = (bf16*)(ws + WS_WOUT0); bf16* Win1 = (bf16*)(ws + WS_WIN1); bf16* Wout1 = (bf16*)(ws + WS_WOUT1); bf16* PoolT = (bf16*)(ws + WS_POOL);
    bf16* Hb = (bf16*)(ws + WS_H); bf16* Yb = (bf16*)(ws + WS_Y); bf16* Pb = (bf16*)(ws + WS_PROJ);
    PG8_LAS unsigned char* lds3 = (PG8_LAS unsigned char*)lds;
#define IN(k) (lo <= (k) && (k) < hi)
#ifdef PROBE_SPAN
    unsigned long long ts_[10]; ts_[0] = __builtin_amdgcn_s_memrealtime();
#define STAMP(k) ts_[(k) + 1] = __builtin_amdgcn_s_memrealtime()
#else
#define STAMP(k) do {} while (0)
#endif
#define SEAM(k) do { if (IN(k) && IN((k) + 1)) grid.sync(); STAMP(k); } while (0)

    if (IN(0)) _Pragma("unroll") for (int rp_ = 0; rp_ < REP0; ++rp_) {
        float* scr = (float*)(lds + wid * 16384);
        constexpr int I_IN0 = 16 * 72, I_OUT = 16 * 32, I_IN1 = 16 * 96, I_POOL = 32;
        constexpr int NITEMS = I_IN0 + I_OUT + I_IN1 + I_OUT + I_POOL;
        for (int it = gw; it < NITEMS; it += NGW) {
            int r = it;
            if (r < I_IN0) { transpose_item(a.in[3], 1024, P0W, Win0, 0, scr, r, lane); continue; } r -= I_IN0;
            if (r < I_OUT) { transpose_item(a.in[7], 1024, 1024, Wout0, 0, scr, r, lane); continue; } r -= I_OUT;
            if (r < I_IN1) { const int n0 = 32 * (r % 96);
                const int d0 = (n0 < 2048) ? (((n0 & 1023) >> 7) * 256 + (n0 >> 10) * 128 + (n0 & 127)) : n0;
                transpose_item(a.in[8], 1024, P1W, Win1, d0 - n0, scr, r, lane); continue; } r -= I_IN1;
            if (r < I_OUT) { transpose_item(a.in[13], 1024, 1024, Wout1, 0, scr, r, lane); continue; } r -= I_OUT;
            { const int gi = r >> 3; transpose_item(a.in[5] + gi * 16384, 128, 128, PoolT + gi * 16384, 0, scr, r & 7, lane); }
        }
        for (int m = gw * 4; m < TOK; m += NGW * 4) norm_rows_bf16<4>(x + (size_t)m * DM, pre_norm, Hb + (size_t)m * DM, lane);
    }
    SEAM(0);
    if (IN(1)) _Pragma("unroll") for (int rp_ = 0; rp_ < REP1; ++rp_) {
        pg8::Gemm g{Hb, Win0, TOK, P0W, DM}; pg8::StaticOrder S; S.init(TOK, P0W, G, bid);
        pg8::EpiBf16<0> E{Pb, P0W, nullptr, 0, 0, 1.f};
        pg8::gemm_phase<pg8::EpiBf16<0>, pg8::StaticOrder, true, true>(lds3, g, S, E);
    }
    SEAM(1);
    if (IN(2)) _Pragma("unroll") for (int rp_ = 0; rp_ < REP2; ++rp_) {
        __syncthreads();
        attn_phase(Pb, Hb, a.in[4], lds, bid, G, tid);
        pool_phase(Pb, Hb, PoolT, a.in[6], lds, bid, G, tid);
    }
    SEAM(2);
    if (IN(3)) _Pragma("unroll") for (int rp_ = 0; rp_ < REP3; ++rp_) {
        pg8::Gemm g{Hb, Wout0, TOK, DM, DM}; pg8::StaticOrder S; S.init(TOK, DM, G, bid);
        pg8::EpiBf16<0> E{Yb, DM, nullptr, 0, 0, 1.f};
        pg8::gemm_phase<pg8::EpiBf16<0>, pg8::StaticOrder, true, true>(lds3, g, S, E);
    }
    SEAM(3);
    if (IN(4)) _Pragma("unroll") for (int rp_ = 0; rp_ < REP4; ++rp_) {
        for (int m = gw * 2; m < TOK; m += NGW * 2) resid_rows<2, true>(x + (size_t)m * DM, Yb + (size_t)m * DM, post_norm, pre_norm + DM, a.out + (size_t)m * DM, Hb + (size_t)m * DM, lane);
    }
    SEAM(4);
    if (IN(5)) _Pragma("unroll") for (int rp_ = 0; rp_ < REP5; ++rp_) {
        pg8::Gemm g{Hb, Win1, TOK, P1W, DM}; pg8::StaticOrder S; S.init(TOK, P1W, G, bid);
        pg8::EpiGlu E{Pb};
        pg8::gemm_phase<pg8::EpiGlu, pg8::StaticOrder, true, true>(lds3, g, S, E);
    }
    SEAM(5);
    if (IN(6)) _Pragma("unroll") for (int rp_ = 0; rp_ < REP6; ++rp_) {
        __syncthreads();
        conv_phase(Pb, Hb, a.in[9], a.in[10], a.in[11], a.in[12], lds, bid, G, tid);
    }
    SEAM(6);
    if (IN(7)) _Pragma("unroll") for (int rp_ = 0; rp_ < REP7; ++rp_) {
        pg8::Gemm g{Hb, Wout1, TOK, DM, DM}; pg8::StaticOrder S; S.init(TOK, DM, G, bid);
        pg8::EpiBf16<0> E{Yb, DM, nullptr, 0, 0, 1.f};
        pg8::gemm_phase<pg8::EpiBf16<0>, pg8::StaticOrder, true, true>(lds3, g, S, E);
    }
    SEAM(7);
    if (IN(8)) {
        for (int m = gw * 2; m < TOK; m += NGW * 2) resid_rows<2, false>(a.out + (size_t)m * DM, Yb + (size_t)m * DM, post_norm + DM, nullptr, a.out + (size_t)m * DM, nullptr, lane);
    }
#ifdef PROBE_SPAN
    {
        ts_[9] = __builtin_amdgcn_s_memrealtime();
        if (bid == 0) { const unsigned long long d = (ts_[PROBE_HI] - ts_[PROBE_LO]) * PROBE_MUL, t0 = __builtin_amdgcn_s_memrealtime();
            while (__builtin_amdgcn_s_memrealtime() - t0 < d) __builtin_amdgcn_s_sleep(8); }
    }
#endif
#undef IN
#undef SEAM
}

extern "C" void kernel_launch(void* const* d_in, const int* in_sizes, int n_in, void* d_out, int out_size, void* d_ws, size_t ws_size, hipStream_t stream) {
    static int grid = 0;
    if (grid == 0) {
        if (n_in != 14 || out_size != TOK * DM || ws_size < WS_END) { fprintf(stderr, "kernel_launch: unexpected shapes (n_in %d, out %d, ws %zu)\n", n_in, out_size, ws_size); grid = -1; return; }
        int dev = 0, cus = 0, per_cu = 0;
        hipGetDevice(&dev);
        hipDeviceGetAttribute(&cus, hipDeviceAttributeMultiprocessorCount, dev);
        if (hipFuncSetAttribute((const void*)fwd_kernel, hipFuncAttributeMaxDynamicSharedMemorySize, LDS_BYTES) != hipSuccess) { fprintf(stderr, "kernel_launch: hipFuncSetAttribute failed\n"); grid = -1; return; }
        if (hipOccupancyMaxActiveBlocksPerMultiprocessor(&per_cu, (const void*)fwd_kernel, 512, LDS_BYTES) != hipSuccess || per_cu < 1) { fprintf(stderr, "kernel_launch: occupancy query says %d\n", per_cu); per_cu = 1; }
        (void)hipGetLastError();
        grid = cus * 1;
        if (grid <= 0) grid = 256;
    }
    if (grid < 0) return;
    Args a{};
    for (int i = 0; i < 14; ++i) a.in[i] = (const float*)d_in[i];
    a.out = (float*)d_out; a.ws = (unsigned char*)d_ws;
#if N_LAUNCH_MODE == 1
    a.ph_lo = 0; a.ph_hi = NPHASE;
    void* args[] = {&a};
    hipError_t e = hipLaunchCooperativeKernel((const void*)fwd_kernel, dim3(grid), dim3(512), args, LDS_BYTES, stream);
    if (e != hipSuccess) fprintf(stderr, "cooperative launch failed: %s (grid %d)\n", hipGetErrorString(e), grid);
#else
    for (int p = 0; p < NPHASE; ++p) {
        a.ph_lo = p; a.ph_hi = p + 1;
        hipLaunchKernelGGL(fwd_kernel, dim3(grid), dim3(512), LDS_BYTES, stream, a);
    }
#endif
}
```
